# Optimizing an MI355X kernel written in HIP

```python
import math
import jax, jax.numpy as jnp
from jax import lax
import numpy as np

D_MODEL = 2048
BATCH = 4
SEQ = 4096
DEPTH = 2

HEAD_DIM = 128
Q_BLOCK = 128
ROPE_THETA = 10000.0
FOX_HEADS = 8
FOX_WIDTH = FOX_HEADS * HEAD_DIM
FORGET_BIAS_INIT = 2.0
SWA_Q_HEADS = 8
SWA_KV_HEADS = 2
SWA_WINDOW = 128
SWA_Q_WIDTH = SWA_Q_HEADS * HEAD_DIM
SWA_KV_WIDTH = SWA_KV_HEADS * HEAD_DIM
EVEN_MIX_WIDTH = FOX_WIDTH + SWA_Q_WIDTH
MLA_HEADS = 16
MLA_Q_RANK = 512
MLA_KV_RANK = 512
MLA_NOPE_DIM = 128
MLA_ROPE_DIM = 64
MLA_V_DIM = 128
D_FF_DENSE = 5632
N_EXPERTS = 8
TOP_K = 2
D_FF_EXPERT = 7168
MOE_BLOCK = 128
LN_EPS = 1e-5
RMS_EPS = 1e-6
DEEPNORM_ALPHA = (2 * DEPTH) ** 0.25
DEEPNORM_BETA = (8 * DEPTH) ** -0.25

kernel_name = 'hybrid_fox_swa_mla_moe_deepnorm'


def _split(t, sizes):
    return jnp.split(t, [int(v) for v in np.cumsum(sizes)[:-1]], axis=-1)


def layer_norm(x, g, b):
    xf = x.astype(jnp.float32)
    mu = jnp.mean(xf, axis=-1, keepdims=True)
    var = jnp.mean(jnp.square(xf - mu), axis=-1, keepdims=True)
    return ((xf - mu) * lax.rsqrt(var + LN_EPS) * g.astype(jnp.float32) + b.astype(jnp.float32)).astype(x.dtype)


def rms_norm(x, g):
    xf = x.astype(jnp.float32)
    ms = jnp.mean(jnp.square(xf), axis=-1, keepdims=True)
    return (xf * lax.rsqrt(ms + RMS_EPS) * g.astype(jnp.float32)).astype(x.dtype)


def rope(x, positions):
    d = x.shape[-1]
    half = d // 2
    inv_freq = ROPE_THETA ** (-2.0 * jnp.arange(half, dtype=jnp.float32) / d)
    ang = positions.astype(jnp.float32)[..., None] * inv_freq
    cos = jnp.cos(ang)[:, :, None, :]
    sin = jnp.sin(ang)[:, :, None, :]
    xf = x.astype(jnp.float32)
    x1, x2 = xf[..., :half], xf[..., half:]
    return jnp.concatenate([x1 * cos - x2 * sin, x2 * cos + x1 * sin], axis=-1).astype(x.dtype)


def causal_block_attention(q, k, v, scale, cum_log_f=None):
    B, S, H, _ = q.shape
    n_blocks = S // Q_BLOCK
    kpos = jnp.arange(S)
    if cum_log_f is not None:
        c_keys = jnp.transpose(cum_log_f, (0, 2, 1))[:, :, None, :]

    def one_block(i):
        start = i * Q_BLOCK
        qb = lax.dynamic_slice_in_dim(q, start, Q_BLOCK, axis=1)
        s = jnp.einsum('bqhd,bkhd->bhqk', qb, k).astype(jnp.float32) * scale
        if cum_log_f is not None:
            cq = lax.dynamic_slice_in_dim(cum_log_f, start, Q_BLOCK, axis=1)
            s = s + (jnp.transpose(cq, (0, 2, 1))[..., None] - c_keys)
        qpos = start + jnp.arange(Q_BLOCK)
        causal = qpos[:, None] >= kpos[None, :]
        s = jnp.where(causal, s, -jnp.inf)
        p = jax.nn.softmax(s, axis=-1)
        return jnp.einsum('bhqk,bkhd->bqhd', p.astype(v.dtype), v)

    out = lax.map(one_block, jnp.arange(n_blocks))
    return jnp.transpose(out, (1, 0, 2, 3, 4)).reshape(B, S, H, v.shape[-1])


def sliding_window_sink_attention(q, k, v, sinks, scale):
    B, S, Hq, d = q.shape
    Hkv = k.shape[2]
    G = Hq // Hkv
    W = SWA_WINDOW
    nb = S // W
    qb = q.reshape(B, nb, W, Hkv, G, d)

    def band(t):
        tb = t.reshape(B, nb, W, Hkv, d)
        prev = jnp.concatenate([jnp.zeros_like(tb[:, :1]), tb[:, :-1]], axis=1)
        return jnp.concatenate([prev, tb], axis=2)

    kb, vb = band(k), band(v)
    s = jnp.einsum('bnqkgd,bnjkd->bnkgqj', qb, kb).astype(jnp.float32) * scale
    qi = jnp.arange(W)[:, None]
    ji = jnp.arange(2 * W)[None, :]
    in_window = (ji > qi) & (ji <= qi + W)
    key_exists = (jnp.arange(nb) > 0)[:, None, None] | (ji >= W)[None]
    mask = in_window[None] & key_exists
    s = jnp.where(mask[None, :, None, None], s, -jnp.inf)
    sink = sinks.astype(jnp.float32).reshape(1, 1, Hkv, G, 1, 1)
    m = jnp.maximum(jnp.max(s, axis=-1, keepdims=True), sink)
    p = jnp.exp(s - m)
    denom = jnp.sum(p, axis=-1, keepdims=True) + jnp.exp(sink - m)
    o = jnp.einsum('bnkgqj,bnjkd->bnqkgd', (p / denom).astype(v.dtype), vb)
    return o.reshape(B, S, Hq, d)


def even_mixer(x, positions, w_in0, b_forget, sinks_b, w_out0):
    B, S, _ = x.shape
    q_a, k_a, v_a, f_a, q_b, k_b, v_b = _split(
        x @ w_in0, [FOX_WIDTH, FOX_WIDTH, FOX_WIDTH, FOX_HEADS, SWA_Q_WIDTH, SWA_KV_WIDTH, SWA_KV_WIDTH])
    heads = lambda t, h: t.reshape(B, S, h, HEAD_DIM)
    log_f = jax.nn.log_sigmoid((f_a + b_forget).astype(jnp.float32))
    cum_log_f = jnp.cumsum(log_f, axis=1)
    o_a = causal_block_attention(heads(q_a, FOX_HEADS), heads(k_a, FOX_HEADS), heads(v_a, FOX_HEADS),
                                 HEAD_DIM ** -0.5, cum_log_f)
    qr = rope(heads(q_b, SWA_Q_HEADS), positions)
    kr = rope(heads(k_b, SWA_KV_HEADS), positions)
    o_b = sliding_window_sink_attention(qr, kr, heads(v_b, SWA_KV_HEADS), sinks_b, HEAD_DIM ** -0.5)
    o = jnp.concatenate([o_a.reshape(B, S, FOX_WIDTH), o_b.reshape(B, S, SWA_Q_WIDTH)], axis=-1)
    return o @ w_out0


def mla_mixer(x, positions, w_in1, q_norm_g, w_uq, kv_norm_g, w_ukv, w_out1):
    B, S, _ = x.shape
    c_q, c_kv, k_pe = _split(x @ w_in1, [MLA_Q_RANK, MLA_KV_RANK, MLA_ROPE_DIM])
    q = (rms_norm(c_q, q_norm_g) @ w_uq).reshape(B, S, MLA_HEADS, MLA_NOPE_DIM + MLA_ROPE_DIM)
    q_nope, q_pe = q[..., :MLA_NOPE_DIM], rope(q[..., MLA_NOPE_DIM:], positions)
    k_pe = rope(k_pe[:, :, None, :], positions)
    kv = (rms_norm(c_kv, kv_norm_g) @ w_ukv).reshape(B, S, MLA_HEADS, MLA_NOPE_DIM + MLA_V_DIM)
    k_nope, v = kv[..., :MLA_NOPE_DIM], kv[..., MLA_NOPE_DIM:]
    q_full = jnp.concatenate([q_nope, q_pe], axis=-1)
    k_full = jnp.concatenate([k_nope, jnp.broadcast_to(k_pe, (B, S, MLA_HEADS, MLA_ROPE_DIM))], axis=-1)
    o = causal_block_attention(q_full, k_full, v, (MLA_NOPE_DIM + MLA_ROPE_DIM) ** -0.5)
    return o.reshape(B, S, MLA_HEADS * MLA_V_DIM) @ w_out1


def swiglu(x, w_gate, w_up, w_down):
    return (jax.nn.silu(x @ w_gate) * (x @ w_up)) @ w_down


def moe_swiglu(x, w_router, w_moe_gate, w_moe_up, w_moe_down):
    B, S, D = x.shape
    xt = x.reshape(B * S, D)
    N = xt.shape[0]
    logits = (xt @ w_router).astype(jnp.float32)
    top_val, top_idx = lax.top_k(logits, TOP_K)
    gates = jax.nn.softmax(top_val, axis=-1)
    A = N * TOP_K
    expert_of = top_idx.reshape(A).astype(jnp.int32)
    token_of = jnp.repeat(jnp.arange(N, dtype=jnp.int32), TOP_K)
    gate_of = gates.reshape(A)
    order = jnp.argsort(expert_of)
    e_sorted = expert_of[order]
    counts = jnp.bincount(expert_of, length=N_EXPERTS)
    group_start = jnp.cumsum(counts) - counts
    padded = ((counts + MOE_BLOCK - 1) // MOE_BLOCK) * MOE_BLOCK
    padded_end = jnp.cumsum(padded)
    padded_start = padded_end - padded
    dest = padded_start[e_sorted] + (jnp.arange(A) - group_start[e_sorted])
    n_blocks = -(-A // MOE_BLOCK) + N_EXPERTS
    n_rows = n_blocks * MOE_BLOCK
    row_token = jnp.zeros((n_rows,), jnp.int32).at[dest].set(token_of[order])
    row_gate = jnp.zeros((n_rows,), jnp.float32).at[dest].set(gate_of[order])
    block_start = jnp.arange(n_blocks, dtype=padded_end.dtype) * MOE_BLOCK
    block_expert = jnp.minimum(jnp.searchsorted(padded_end, block_start, side='right'), N_EXPERTS - 1)

    def one_block(args):
        tok, e = args
        return swiglu(xt[tok], w_moe_gate[e], w_moe_up[e], w_moe_down[e])

    y_rows = lax.map(one_block, (row_token.reshape(n_blocks, MOE_BLOCK), block_expert))
    y_rows = y_rows.reshape(n_rows, D) * row_gate[:, None].astype(y_rows.dtype)
    y = jnp.zeros_like(xt).at[row_token].add(y_rows)
    return y.reshape(B, S, D)


def setup_inputs(seed: int = 0) -> dict:
    key = jax.random.key(seed)
    ks = iter(jax.random.split(key, 40))
    f32 = jnp.float32
    nrm = lambda shape, scale: jax.random.normal(next(ks), shape, f32) * scale
    proj = lambda shape, fan_in, g=1.0: nrm(shape, g * fan_in ** -0.5)
    gain = lambda n: 1.0 + nrm((n,), 0.02)
    bias = lambda n: nrm((n,), 0.02)
    beta = DEEPNORM_BETA

    x = nrm((BATCH, SEQ, D_MODEL), 1.0)
    start = jax.random.randint(next(ks), (BATCH, 1), 0, 1024, dtype=jnp.int32)
    positions = start + jnp.arange(SEQ, dtype=jnp.int32)[None, :]
    w_in0 = jnp.concatenate([
        proj((D_MODEL, 2 * FOX_WIDTH), D_MODEL),
        proj((D_MODEL, FOX_WIDTH), D_MODEL, beta),
        proj((D_MODEL, FOX_HEADS), D_MODEL),
        proj((D_MODEL, SWA_Q_WIDTH + SWA_KV_WIDTH), D_MODEL),
        proj((D_MODEL, SWA_KV_WIDTH), D_MODEL, beta)], axis=1)
    b_forget = FORGET_BIAS_INIT + nrm((FOX_HEADS,), 0.5)
    sinks_b = nrm((SWA_Q_HEADS,), 0.5)
    w_out0 = proj((EVEN_MIX_WIDTH, D_MODEL), EVEN_MIX_WIDTH, beta)
    ln0_mix_g, ln0_mix_b = gain(D_MODEL), bias(D_MODEL)
    w_ffn_gate = proj((D_MODEL, D_FF_DENSE), D_MODEL, beta)
    w_ffn_up = proj((D_MODEL, D_FF_DENSE), D_MODEL, beta)
    w_ffn_down = proj((D_FF_DENSE, D_MODEL), D_FF_DENSE, beta)
    ln0_ffn_g, ln0_ffn_b = gain(D_MODEL), bias(D_MODEL)
    w_in1 = proj((D_MODEL, MLA_Q_RANK + MLA_KV_RANK + MLA_ROPE_DIM), D_MODEL)
    q_norm_g = gain(MLA_Q_RANK)
    w_uq = proj((MLA_Q_RANK, MLA_HEADS * (MLA_NOPE_DIM + MLA_ROPE_DIM)), MLA_Q_RANK)
    kv_norm_g = gain(MLA_KV_RANK)
    w_ukv = jnp.concatenate([
        proj((MLA_KV_RANK, MLA_HEADS, MLA_NOPE_DIM), MLA_KV_RANK),
        proj((MLA_KV_RANK, MLA_HEADS, MLA_V_DIM), MLA_KV_RANK, beta)], axis=-1
    ).reshape(MLA_KV_RANK, MLA_HEADS * (MLA_NOPE_DIM + MLA_V_DIM))
    w_out1 = proj((MLA_HEADS * MLA_V_DIM, D_MODEL), MLA_HEADS * MLA_V_DIM, beta)
    ln1_mix_g, ln1_mix_b = gain(D_MODEL), bias(D_MODEL)
    w_router = proj((D_MODEL, N_EXPERTS), D_MODEL)
    w_moe_gate = proj((N_EXPERTS, D_MODEL, D_FF_EXPERT), D_MODEL, beta)
    w_moe_up = proj((N_EXPERTS, D_MODEL, D_FF_EXPERT), D_MODEL, beta)
    w_moe_down = proj((N_EXPERTS, D_FF_EXPERT, D_MODEL), D_FF_EXPERT, beta)
    ln1_ffn_g, ln1_ffn_b = gain(D_MODEL), bias(D_MODEL)
    return {'x': x, 'positions': positions,
            'w_in0': w_in0, 'b_forget': b_forget, 'sinks_b': sinks_b, 'w_out0': w_out0,
            'ln0_mix_g': ln0_mix_g, 'ln0_mix_b': ln0_mix_b,
            'w_ffn_gate': w_ffn_gate, 'w_ffn_up': w_ffn_up, 'w_ffn_down': w_ffn_down,
            'ln0_ffn_g': ln0_ffn_g, 'ln0_ffn_b': ln0_ffn_b,
            'w_in1': w_in1, 'q_norm_g': q_norm_g, 'w_uq': w_uq, 'kv_norm_g': kv_norm_g,
            'w_ukv': w_ukv, 'w_out1': w_out1, 'ln1_mix_g': ln1_mix_g, 'ln1_mix_b': ln1_mix_b,
            'w_router': w_router, 'w_moe_gate': w_moe_gate, 'w_moe_up': w_moe_up,
            'w_moe_down': w_moe_down, 'ln1_ffn_g': ln1_ffn_g, 'ln1_ffn_b': ln1_ffn_b}


def reference(x, positions, w_in0, b_forget, sinks_b, w_out0, ln0_mix_g, ln0_mix_b,
              w_ffn_gate, w_ffn_up, w_ffn_down, ln0_ffn_g, ln0_ffn_b,
              w_in1, q_norm_g, w_uq, kv_norm_g, w_ukv, w_out1, ln1_mix_g, ln1_mix_b,
              w_router, w_moe_gate, w_moe_up, w_moe_down, ln1_ffn_g, ln1_ffn_b):
    h = x
    for layer in range(DEPTH):
        if layer % 2 == 0:
            h = layer_norm(DEEPNORM_ALPHA * h + even_mixer(h, positions, w_in0, b_forget, sinks_b, w_out0),
                           ln0_mix_g, ln0_mix_b)
            h = layer_norm(DEEPNORM_ALPHA * h + swiglu(h, w_ffn_gate, w_ffn_up, w_ffn_down),
                           ln0_ffn_g, ln0_ffn_b)
        else:
            h = layer_norm(DEEPNORM_ALPHA * h + mla_mixer(h, positions, w_in1, q_norm_g, w_uq,
                                                          kv_norm_g, w_ukv, w_out1),
                           ln1_mix_g, ln1_mix_b)
            h = layer_norm(DEEPNORM_ALPHA * h + moe_swiglu(h, w_router, w_moe_gate, w_moe_up, w_moe_down),
                           ln1_ffn_g, ln1_ffn_b)
    return h
```

```cpp
#include <hip/hip_runtime.h>
#include <cstdio>
#include <cstdint>
#include <cmath>

#define LAS __attribute__((address_space(3)))
typedef unsigned short bf16_t;
typedef short bf16x8 __attribute__((ext_vector_type(8)));
typedef short s16x4 __attribute__((ext_vector_type(4)));
typedef float f32x4 __attribute__((ext_vector_type(4)));
typedef float f32x2 __attribute__((ext_vector_type(2)));
typedef float f32x16 __attribute__((ext_vector_type(16)));
typedef unsigned u32x4 __attribute__((ext_vector_type(4)));
typedef unsigned u32x2 __attribute__((ext_vector_type(2)));

constexpr int NTOK = 16384, DM = 2048, SEQ = 4096, NBATCH = 4;
constexpr int FFD = 5632, FFE = 7168, NEXP = 8;
constexpr int MOE_TILES_MAX = 136;
constexpr float LN_EPS = 1e-5f, RMS_EPS = 1e-6f;
constexpr float DN_ALPHA = 1.4142135623730951f;

__device__ __forceinline__ unsigned cvt_pk_bf16(float lo, float hi) { unsigned r; asm volatile("v_cvt_pk_bf16_f32 %0, %1, %2" : "=v"(r) : "v"(lo), "v"(hi)); return r; }

#define XB_TMO      128
#define XB_XCNT(j)  (256  + 64 * (j))
#define XB_XSUB(j)  (1280 + 64 * (j))
#define XB_XGEN(j)  (2304 + 64 * (j))
#define XB_TOP      3328
#define XB_TOPGEN   3392
#define XCD_BAR_WORDS 3456
#define XB_SPIN_CAP (1u << 20)
__device__ __forceinline__ unsigned xb_ld(unsigned* p)              { return __hip_atomic_load(p, __ATOMIC_RELAXED, __HIP_MEMORY_SCOPE_AGENT); }
__device__ __forceinline__ unsigned xb_add(unsigned* p, unsigned v) { return __hip_atomic_fetch_add(p, v, __ATOMIC_RELAXED, __HIP_MEMORY_SCOPE_AGENT); }
__device__ __forceinline__ unsigned xb_xcc_id() { return (unsigned)__builtin_amdgcn_s_getreg((3 << 11) | 20) & 0xFu; }
#define XB_SPIN(cond, bar) do { unsigned _sp = 0; while (cond) { __builtin_amdgcn_s_sleep(1); \
    if ((++_sp & 255u) == 0u) { if (xb_ld(&(bar)[XB_TMO])) break; if (_sp > XB_SPIN_CAP) { atomicAdd(&(bar)[XB_TMO], 1u); break; } } } } while (0)
struct XcdBarrier { unsigned* bar; unsigned x; volatile LAS unsigned* st; };
__device__ __forceinline__ XcdBarrier xcd_barrier_post(unsigned* bar, volatile LAS unsigned* st, const int tid) {
    XcdBarrier b; b.bar = bar; b.x = xb_xcc_id(); b.st = st;
    if (tid == 0) (void)xb_add(&bar[XB_XCNT(b.x)], 1u);
    return b;
}
__device__ __forceinline__ void xcd_barrier_complete(unsigned* bar, unsigned x, unsigned& nloc, unsigned& nx) {
    const unsigned G = gridDim.x * gridDim.y * gridDim.z;
    unsigned sum, cnt, mine, sp = 0u;
    for (;;) {
        sum = 0u; cnt = 0u; mine = 0u;
#pragma unroll
        for (unsigned j = 0; j < 16; ++j) { const unsigned c = xb_ld(&bar[XB_XCNT(j)]); sum += c; cnt += (c > 0u) ? 1u : 0u; mine = (j == x) ? c : mine; }
        if (sum == G) break;
        __builtin_amdgcn_s_sleep(1);
        if ((++sp & 255u) == 0u) { if (xb_ld(&bar[XB_TMO])) break; if (sp > XB_SPIN_CAP) { atomicAdd(&bar[XB_TMO], 1u); break; } }
    }
    nloc = mine > 0u ? mine : 1u; nx = cnt > 0u ? cnt : 1u;
}
__device__ __forceinline__ void xcd_barrier(const XcdBarrier& b, const int tid) {
    asm volatile("s_waitcnt vmcnt(0)" ::: "memory");
    __syncthreads();
    if (tid == 0) {
        unsigned* bar = b.bar;
        __builtin_amdgcn_s_waitcnt(0);
        unsigned nloc = b.st[0], nx = b.st[1];
        if (nloc == 0u) { xcd_barrier_complete(bar, b.x, nloc, nx); b.st[0] = nloc; b.st[1] = nx; }
        const unsigned old = xb_add(&bar[XB_XSUB(b.x)], 1u);
        const unsigned gen = old / nloc;
        if (old + 1u == (gen + 1u) * nloc) {
            __builtin_amdgcn_fence(__ATOMIC_RELEASE, "agent");
            asm volatile("s_waitcnt vmcnt(0)" ::: "memory");
            const unsigned og = xb_add(&bar[XB_TOP], 1u);
            const unsigned tg = og / nx;
            if (og + 1u == (tg + 1u) * nx) xb_add(&bar[XB_TOPGEN], 1u);
            else XB_SPIN(xb_ld(&bar[XB_TOPGEN]) == tg, bar);
            __builtin_amdgcn_fence(__ATOMIC_ACQUIRE, "agent");
            xb_add(&bar[XB_XGEN(b.x)], 1u);
            asm volatile("s_waitcnt vmcnt(0)" ::: "memory");
        } else {
            XB_SPIN(xb_ld(&bar[XB_XGEN(b.x)]) == gen, bar);
            __builtin_amdgcn_fence(__ATOMIC_ACQUIRE, "agent");
            asm volatile("s_waitcnt vmcnt(0)" ::: "memory");
        }
    }
    __syncthreads();
}

namespace pg8 {
constexpr int BM = 256, BK = 64, HALF = 128, HTB = HALF * BK * 2, STAGE_BYTES = 8 * HTB, NXCD = 8, WGM = 8;
__host__ __device__ __forceinline__ int lds_byte(int r, int c) { const int st = (r >> 4) * 2 + (c >> 5), rr = r & 15, cc = c & 31, ob = rr * 64 + cc * 2; return st * 1024 + (ob ^ (((ob >> 9) & 1) << 5)); }
__host__ __device__ __forceinline__ void stage_rc(int b, int& R, int& C) { const int st = b / 1024, sb = b % 1024, swz = sb ^ (((sb >> 9) & 1) << 5); R = (st >> 1) * 16 + swz / 64; C = (st & 1) * 32 + (swz % 64) / 2; }
__host__ __device__ __forceinline__ int perm32(int rho) { const int n = rho >> 4, i = rho & 15; return 8 * (i >> 2) + 4 * n + (i & 3); }

struct Unit { int pm, pn, e, kt0, nkt, buf; };
struct Gemm { const bf16_t* A; const bf16_t* Bt; int K; size_t estride; float qs = 1.0f, qs_b1 = 1.0f; };

struct TileOrder {
    int nM, nN, nwg, G, c, nt; const int* ts;
    __device__ __forceinline__ void init(int nM_, int nN_, int G_, int c_, const int* ts_, int nt_) { nM = nM_; nN = nN_; nwg = nM * nN; G = G_; c = c_; ts = ts_; nt = nt_; }
    __device__ __forceinline__ bool next(int i, Unit& u) const {
        const long L = (long)i * G + c; if (L >= nwg) return false;
        int wgid = (int)L; { const int q = nwg / NXCD, r = nwg % NXCD, xcd = wgid % NXCD, off = wgid / NXCD; wgid = (xcd < r ? xcd * (q + 1) : r * (q + 1) + (xcd - r) * q) + off; }
        const int nig = WGM * nN, gid = wgid / nig, fm = gid * WGM, gsz = (nM - fm) < WGM ? (nM - fm) : WGM;
        u.pm = fm + ((wgid % nig) % gsz); u.pn = (wgid % nig) / gsz; u.e = 0; u.kt0 = 0; u.nkt = nt; u.buf = 0;
        if (ts) { int e = 0;
#pragma unroll
            for (int j = 1; j < 8; ++j) e += (u.pm >= ts[j]) ? 1 : 0;
            u.e = e; }
        return true;
    }
};

__device__ __forceinline__ void splitk_plan(int nM, int nN, int nt, int G, int& main_m, int& s) {
    main_m = ((nM * nN) / G) * G / nN; const int R = (nM - main_m) * nN; s = 1;
    if (R > 0) { const int cap = G / R; const int cand[8] = {1, 2, 4, 7, 8, 14, 28, 56};
#pragma unroll
        for (int i = 0; i < 8; ++i) if (cand[i] <= cap && nt % (2 * cand[i]) == 0) s = cand[i]; }
}
struct SplitKOrder {
    int nN, R, s, main_m, nkt, v; const int* ts;
    __device__ __forceinline__ void init(int nM, int nN_, int nt, int G, int v_, const int* ts_) { nN = nN_; ts = ts_; v = v_; splitk_plan(nM, nN, nt, G, main_m, s); R = (nM - main_m) * nN; nkt = nt / s; }
    __device__ __forceinline__ bool next(int i, Unit& u) const {
        if (i > 0 || v >= R * s) return false;
        const int ks = v % s, r = v / s;
        u.pm = main_m + r / nN; u.pn = r % nN; u.kt0 = ks * nkt; u.nkt = nkt; u.buf = ks; u.e = 0;
        if (ts) { int e = 0;
#pragma unroll
            for (int j = 1; j < 8; ++j) e += (u.pm >= ts[j]) ? 1 : 0;
            u.e = e; }
        return true;
    }
};

typedef int v8i __attribute__((ext_vector_type(8)));
typedef int v4i __attribute__((ext_vector_type(4)));
__device__ __forceinline__ v8i cat8(const bf16x8 a, const bf16x8 b) { const u32x4 x = __builtin_bit_cast(u32x4, a), y = __builtin_bit_cast(u32x4, b); return (v8i){(int)x[0], (int)x[1], (int)x[2], (int)x[3], (int)y[0], (int)y[1], (int)y[2], (int)y[3]}; }
template <class Epi, class Sched, int QM = 0, bool SWAP = false>
__device__ __forceinline__ void gemm_phase(LAS unsigned char* lds, const Gemm g, const Sched& S, const Epi& E, const int tid) {
    const int wid = __builtin_amdgcn_readfirstlane(tid >> 6), lane = tid & 63, wr = wid >> 2, wc = wid & 3, fr = lane & 15, fq = lane >> 4;
    const int K = g.K;
    unsigned voffA[2], voffB[2];
#pragma unroll
    for (int i = 0; i < 2; ++i) { int R, C; stage_rc(tid * 16 + i * 8192, R, C); const int Rb = Epi::PERM ? ((R & ~31) + perm32(R & 31)) : R;
        voffA[i] = (unsigned)(R * K + C) * 2u; voffB[i] = (unsigned)(Rb * K + C) * 2u; }
    const size_t kstep = (size_t)(BK * 2);
    const size_t hstep = (size_t)HALF * K * 2;
    const size_t tstep = 2 * hstep;
    const unsigned ldsw = (unsigned)wid * 1024u;
    const int aoff = lds_byte(wr * 64 + fr, fq * 8), boff = lds_byte(wc * 32 + fr, fq * 8);
#define PG8_SA(b, h) (((b) * 2 + (h)) * HTB)
#define PG8_SB(b, h) ((4 + (b) * 2 + (h)) * HTB)
#define PG8_STAGE(bufoff, gbase, voff) do { _Pragma("unroll") for (int _i = 0; _i < 2; ++_i) \
        __builtin_amdgcn_global_load_lds((const unsigned*)((const char*)(gbase) + (voff)[_i]), (LAS unsigned*)(lds + (bufoff) + ldsw + _i * 8192), 16, 0, 0); } while (0)
#define PG8_LDA(dst, b, h) do { _Pragma("unroll") for (int m = 0; m < 4; ++m) _Pragma("unroll") for (int k = 0; k < 2; ++k) dst[m][k] = *(const LAS bf16x8*)(lds + PG8_SA(b, h) + aoff + m * 2048 + k * 1024); } while (0)
#define PG8_LDB(dst, b, h) do { _Pragma("unroll") for (int n = 0; n < 2; ++n) _Pragma("unroll") for (int k = 0; k < 2; ++k) dst[n][k] = *(const LAS bf16x8*)(lds + PG8_SB(b, h) + boff + n * 2048 + k * 1024); } while (0)
#define PG8_MMA(ai, bj, At, Bt) do { __builtin_amdgcn_s_setprio(1); _Pragma("unroll") for (int m = 0; m < 4; ++m) _Pragma("unroll") for (int n = 0; n < 2; ++n) { \
        if constexpr (QM == 1) { const v8i b8_ = cat8(Bt[n][0], Bt[n][1]), a8_ = cat8(At[m][0], At[m][1]); asm volatile("v_mfma_scale_f32_16x16x128_f8f6f4 %0, %1, %2, %0, %3, %3 op_sel_hi:[0,0,0]" : "+v"(acc[ai][bj][m][n]) : "v"(b8_), "v"(a8_), "v"(sc1_)); } \
        else if constexpr (QM == 2) { _Pragma("unroll") for (int k = 0; k < 2; ++k) acc[ai][bj][m][n] = __builtin_bit_cast(f32x4, SWAP ? __builtin_amdgcn_mfma_i32_16x16x64_i8(__builtin_bit_cast(v4i, At[m][k]), __builtin_bit_cast(v4i, Bt[n][k]), __builtin_bit_cast(v4i, acc[ai][bj][m][n]), 0, 0, 0) \
                                                                                                : __builtin_amdgcn_mfma_i32_16x16x64_i8(__builtin_bit_cast(v4i, Bt[n][k]), __builtin_bit_cast(v4i, At[m][k]), __builtin_bit_cast(v4i, acc[ai][bj][m][n]), 0, 0, 0)); } \
        else { _Pragma("unroll") for (int k = 0; k < 2; ++k) acc[ai][bj][m][n] = __builtin_amdgcn_mfma_f32_16x16x32_bf16(Bt[n][k], At[m][k], acc[ai][bj][m][n], 0, 0, 0); } } __builtin_amdgcn_s_setprio(0); } while (0)
#define PG8_WAIT_V(n) asm volatile("s_waitcnt vmcnt(" #n ")" ::: "memory")
#define PG8_WAIT_L(n) asm volatile("s_waitcnt lgkmcnt(" #n ")" ::: "memory")
#define PG8_BAR __builtin_amdgcn_s_barrier()
#define PG8_SCHED __builtin_amdgcn_sched_barrier(0)
    Unit cur, nxt; int ui = 0;
    if (!S.next(0, cur)) return;
    const int sc1_ = 0x7F7F7F7F; (void)sc1_;
    f32x4 acc[2][2][4][2];
#pragma unroll
    for (int a = 0; a < 2; ++a)
#pragma unroll
        for (int b = 0; b < 2; ++b)
#pragma unroll
            for (int m = 0; m < 4; ++m)
#pragma unroll
                for (int n = 0; n < 2; ++n) acc[a][b][m][n] = (f32x4){0.f, 0.f, 0.f, 0.f};
    bf16x8 At[4][2], B0[2][2], B1[2][2];
    const char* cA = (const char*)g.A + (size_t)cur.pm * tstep + (size_t)cur.kt0 * kstep; const char* cB = (const char*)g.Bt + (size_t)cur.e * g.estride + (size_t)cur.pn * tstep + (size_t)cur.kt0 * kstep;
    PG8_STAGE(PG8_SB(0, 0), cB, voffB); PG8_STAGE(PG8_SB(0, 1), cB + hstep, voffB); PG8_STAGE(PG8_SA(0, 0), cA, voffA); PG8_STAGE(PG8_SA(0, 1), cA + hstep, voffA);
    if (wr == 1) PG8_BAR;
    PG8_WAIT_V(2); PG8_BAR;
    PG8_STAGE(PG8_SB(1, 0), cB + kstep, voffB); PG8_STAGE(PG8_SA(1, 0), cA + kstep, voffA); PG8_STAGE(PG8_SB(1, 1), cB + hstep + kstep, voffB);
    PG8_WAIT_V(6); PG8_BAR;
    for (;;) {
        const bool has_next = S.next(ui + 1, nxt);
        const char* nA = has_next ? (const char*)g.A + (size_t)nxt.pm * tstep + (size_t)nxt.kt0 * kstep : cA; const char* nB = has_next ? (const char*)g.Bt + (size_t)nxt.e * g.estride + (size_t)nxt.pn * tstep + (size_t)nxt.kt0 * kstep : cB;
        const int nt = cur.nkt;
        for (int t = 0; t < nt; t += 2) {
            const bool last = (t == nt - 2);
            const char* a1 = cA + (size_t)(t + 1) * kstep;
            const char* a2 = last ? nA : cA + (size_t)(t + 2) * kstep; const char* b2 = last ? nB : cB + (size_t)(t + 2) * kstep;
            const char* a3 = a2 + kstep; const char* b3 = b2 + kstep;
            PG8_LDB(B0, 0, 0); PG8_LDB(B1, 0, 1); PG8_SCHED; PG8_LDA(At, 0, 0); PG8_STAGE(PG8_SA(1, 1), a1 + hstep, voffA);
            PG8_WAIT_V(8); PG8_WAIT_L(0); PG8_BAR; PG8_MMA(0, 0, At, B0); PG8_MMA(0, 1, At, B1); PG8_BAR; PG8_SCHED;
            PG8_LDA(At, 0, 1); PG8_STAGE(PG8_SB(0, 0), b2, voffB); PG8_STAGE(PG8_SB(0, 1), b2 + hstep, voffB); PG8_STAGE(PG8_SA(0, 0), a2, voffA);
            PG8_WAIT_V(8); PG8_WAIT_L(0); PG8_BAR; PG8_MMA(1, 0, At, B0); PG8_MMA(1, 1, At, B1); PG8_BAR; PG8_SCHED;
            PG8_LDB(B0, 1, 0); PG8_LDB(B1, 1, 1); PG8_SCHED; PG8_LDA(At, 1, 0); PG8_STAGE(PG8_SA(0, 1), a2 + hstep, voffA);
            PG8_WAIT_V(8); PG8_WAIT_L(0); PG8_BAR; PG8_MMA(0, 0, At, B0); PG8_MMA(0, 1, At, B1); PG8_BAR; PG8_SCHED;
            PG8_LDA(At, 1, 1); PG8_STAGE(PG8_SB(1, 0), b3, voffB); PG8_STAGE(PG8_SB(1, 1), b3 + hstep, voffB); PG8_STAGE(PG8_SA(1, 0), a3, voffA);
            PG8_WAIT_V(8); PG8_WAIT_L(0); PG8_BAR; PG8_MMA(1, 0, At, B0); PG8_MMA(1, 1, At, B1); PG8_BAR; PG8_SCHED;
        }
        if constexpr (QM == 2) { const float qs0_ = g.qs * E.qscale(cur), qs1_ = qs0_ * g.qs_b1; _Pragma("unroll") for (int a = 0; a < 2; ++a) _Pragma("unroll") for (int b = 0; b < 2; ++b) _Pragma("unroll") for (int m = 0; m < 4; ++m) _Pragma("unroll") for (int n = 0; n < 2; ++n) { const v4i t_ = __builtin_bit_cast(v4i, acc[a][b][m][n]); acc[a][b][m][n] = (f32x4){(float)t_[0], (float)t_[1], (float)t_[2], (float)t_[3]} * (b == 0 ? qs0_ : qs1_); } }
        if constexpr (QM == 1) asm volatile("s_nop 15\n\ts_nop 15\n\ts_nop 15" ::: "memory");
        if (wr == 0) PG8_BAR;
        E(acc, cur, wr, wc, fr, fq);
        if (!has_next) break;
#pragma unroll
        for (int a = 0; a < 2; ++a)
#pragma unroll
            for (int b = 0; b < 2; ++b)
#pragma unroll
                for (int m = 0; m < 4; ++m)
#pragma unroll
                    for (int n = 0; n < 2; ++n) acc[a][b][m][n] = (f32x4){0.f, 0.f, 0.f, 0.f};
        cur = nxt; cA = nA; cB = nB; ++ui;
        if (wr == 1) PG8_BAR;
    }
    PG8_WAIT_V(0);
    PG8_BAR;
#undef PG8_SA
#undef PG8_SB
#undef PG8_STAGE
#undef PG8_LDA
#undef PG8_LDB
#undef PG8_MMA
#undef PG8_WAIT_V
#undef PG8_WAIT_L
#undef PG8_BAR
#undef PG8_SCHED
}

#define EPI_ARGS const f32x4 (&acc)[2][2][4][2], const Unit& u, int wr, int wc, int fr, int fq
__device__ __forceinline__ float clamp448(float x) { return __builtin_amdgcn_fmed3f(x, -448.0f, 448.0f); }
__device__ __forceinline__ u32x2 pack8fp8(const f32x4 a, const f32x4 b) {
    int lo = __builtin_amdgcn_cvt_pk_fp8_f32(clamp448(a[0]), clamp448(a[1]), 0, false); lo = __builtin_amdgcn_cvt_pk_fp8_f32(clamp448(a[2]), clamp448(a[3]), lo, true);
    int hi = __builtin_amdgcn_cvt_pk_fp8_f32(clamp448(b[0]), clamp448(b[1]), 0, false); hi = __builtin_amdgcn_cvt_pk_fp8_f32(clamp448(b[2]), clamp448(b[3]), hi, true);
    return (u32x2){(unsigned)lo, (unsigned)hi}; }
__device__ __forceinline__ unsigned pack4i8(const f32x4 t) {
    const float M = 12582912.f; const unsigned a = __float_as_uint(__builtin_amdgcn_fmed3f(t[0], -127.f, 127.f) + M), b = __float_as_uint(__builtin_amdgcn_fmed3f(t[1], -127.f, 127.f) + M),
                   c = __float_as_uint(__builtin_amdgcn_fmed3f(t[2], -127.f, 127.f) + M), d = __float_as_uint(__builtin_amdgcn_fmed3f(t[3], -127.f, 127.f) + M);
    return __builtin_amdgcn_perm(b, a, 0x0c0c0400u) | __builtin_amdgcn_perm(d, c, 0x04000c0cu); }
__device__ __forceinline__ u32x2 pack8i8(const f32x4 a, const f32x4 b) { return (u32x2){pack4i8(a), pack4i8(b)}; }
__device__ __forceinline__ u32x4 pack8bf(const f32x4 a, const f32x4 b) { u32x4 w; w.x = cvt_pk_bf16(a[0], a[1]); w.y = cvt_pk_bf16(a[2], a[3]); w.z = cvt_pk_bf16(b[0], b[1]); w.w = cvt_pk_bf16(b[2], b[3]); return w; }

struct EpiQKV0 {
    static constexpr bool PERM = true;
    __device__ __forceinline__ float qscale(const Unit& u) const { return ((u.pn >= 8 && u.pn <= 11) || u.pn == 17) ? 0.5f : 1.0f; }
    bf16_t* O; const float* cs; const float* sn; float* nrm;
    __device__ __forceinline__ void operator()(EPI_ARGS) const {
        const int row0 = u.pm * BM + wr * 64 + fr; const bool rot = (u.pn >= 12 && u.pn <= 16); const int fi = 16 * wc + 4 * fq;
#pragma unroll
        for (int ai = 0; ai < 2; ++ai)
#pragma unroll
            for (int m = 0; m < 4; ++m) { const int row = row0 + ai * HALF + m * 16;
                f32x4 c4 = (f32x4){1.f, 1.f, 1.f, 1.f}, s4 = (f32x4){0.f, 0.f, 0.f, 0.f};
                if (rot) { c4 = *(const f32x4*)(cs + (size_t)row * 64 + fi); s4 = *(const f32x4*)(sn + (size_t)row * 64 + fi); }
#pragma unroll
                for (int bj = 0; bj < 2; ++bj) { const int hd = 2 * u.pn + bj; const f32x4 v0 = acc[ai][bj][m][0], v1 = acc[ai][bj][m][1];
                    const f32x4 o0 = v0 * c4 - v1 * s4, o1 = v1 * c4 + v0 * s4;
                    *(u32x4*)(O + ((size_t)hd * NTOK + row) * 128 + 32 * wc + 8 * fq) = pack8bf(o0, o1);
                    if (u.pn < 8) { float s = ((o0[0] * o0[0] + o0[1] * o0[1]) + (o0[2] * o0[2] + o0[3] * o0[3])) + ((o1[0] * o1[0] + o1[1] * o1[1]) + (o1[2] * o1[2] + o1[3] * o1[3]));
                        s += __shfl_xor(s, 16); s += __shfl_xor(s, 32);
                        if (fq == 0) nrm[((size_t)hd * NTOK + row) * 4 + wc] = s; } } }
    }
};
__device__ __forceinline__ void ln_stats(const float* st, int row, float& mu, float& rs) { const f32x2 s = *(const f32x2*)(st + 2 * (size_t)row); mu = s[0] * (1.0f / DM); rs = 1.0f / sqrtf(s[1] * (1.0f / DM) - mu * mu + LN_EPS); }
template <int RESLN, int COPY, bool STATS> struct EpiResLN {
    static constexpr bool PERM = true;
    float* Y; const float* res; const float* stin; const float* lg; const float* lb; float* stout; void* copy; float ascale, cscale;
    __device__ __forceinline__ void operator()(EPI_ARGS) const {
        const int row0 = u.pm * BM + wr * 64 + fr, col0 = u.pn * BM + wc * 32 + 8 * fq;
        f32x4 gg[2][2], bb[2][2];
        if constexpr (RESLN) {
#pragma unroll
            for (int bj = 0; bj < 2; ++bj)
#pragma unroll
                for (int n = 0; n < 2; ++n) { gg[bj][n] = *(const f32x4*)(lg + col0 + bj * HALF + 4 * n); bb[bj][n] = *(const f32x4*)(lb + col0 + bj * HALF + 4 * n); } }
#pragma unroll
        for (int ai = 0; ai < 2; ++ai)
#pragma unroll
            for (int m = 0; m < 4; ++m) { const int row = row0 + ai * HALF + m * 16; const size_t off = (size_t)row * DM + col0;
                float mu = 0.f, rs = 1.f; if constexpr (RESLN) ln_stats(stin, row, mu, rs);
                float ss = 0.f, qq = 0.f;
#pragma unroll
                for (int bj = 0; bj < 2; ++bj) { f32x4 r0 = *(const f32x4*)(res + off + bj * HALF), r1 = *(const f32x4*)(res + off + bj * HALF + 4);
                    if constexpr (RESLN) { r0 = (r0 - mu) * rs * gg[bj][0] + bb[bj][0]; r1 = (r1 - mu) * rs * gg[bj][1] + bb[bj][1]; }
                    const f32x4 y0 = r0 * DN_ALPHA + acc[ai][bj][m][0] * ascale, y1 = r1 * DN_ALPHA + acc[ai][bj][m][1] * ascale;
                    if constexpr (COPY != 4) { *(f32x4*)(Y + off + bj * HALF) = y0; *(f32x4*)(Y + off + bj * HALF + 4) = y1; }
                    if constexpr (STATS) { ss += ((y0[0] + y0[1]) + (y0[2] + y0[3])) + ((y1[0] + y1[1]) + (y1[2] + y1[3]));
                        qq += ((y0[0] * y0[0] + y0[1] * y0[1]) + (y0[2] * y0[2] + y0[3] * y0[3])) + ((y1[0] * y1[0] + y1[1] * y1[1]) + (y1[2] * y1[2] + y1[3] * y1[3])); }
                    if constexpr (COPY == 1) *(u32x2*)((unsigned char*)copy + off + bj * HALF) = pack8fp8(y0 * cscale, y1 * cscale);
                    if constexpr (COPY == 3) *(u32x2*)((unsigned char*)copy + off + bj * HALF) = pack8i8(y0 * cscale, y1 * cscale);
                    if constexpr (COPY == 2 || COPY == 4) *(u32x4*)((bf16_t*)copy + off + bj * HALF) = pack8bf(y0, y1); }
                if constexpr (STATS) { ss += __shfl_xor(ss, 16); ss += __shfl_xor(ss, 32); qq += __shfl_xor(qq, 16); qq += __shfl_xor(qq, 32);
                    if (fq == 0) { unsafeAtomicAdd(stout + 2 * (size_t)row, ss); unsafeAtomicAdd(stout + 2 * (size_t)row + 1, qq); } }
                asm volatile("" ::: "memory"); }
    }
};
template <bool F8OUT, bool FOLD, bool PRE = false> struct EpiSwiGLU {
    static constexpr bool PERM = true;
    void* O; int ldc; float ascale, oscale; const float* st; const float* C; const float* D;
    __device__ __forceinline__ float qscale(const Unit&) const { return 1.0f; }
    __device__ __forceinline__ void operator()(EPI_ARGS) const {
        const int row0 = u.pm * BM + wr * 64 + fr, col0 = u.pn * HALF + wc * 32 + 8 * fq, n0 = u.pn * BM + wc * 32 + 8 * fq;
        f32x4 cg[2], dg[2], cu[2], du[2];
        if constexpr (FOLD) {
#pragma unroll
            for (int n = 0; n < 2; ++n) { cg[n] = *(const f32x4*)(C + n0 + 4 * n); dg[n] = *(const f32x4*)(D + n0 + 4 * n); cu[n] = *(const f32x4*)(C + n0 + HALF + 4 * n); du[n] = *(const f32x4*)(D + n0 + HALF + 4 * n);
                if constexpr (PRE) { float os_ = oscale; asm volatile("" : "+s"(os_)); cu[n] = cu[n] * os_; du[n] = du[n] * os_; } } }
#pragma unroll
        for (int ai = 0; ai < 2; ++ai)
#pragma unroll
            for (int m = 0; m < 4; ++m) { const int row = row0 + ai * HALF + m * 16; f32x4 r[2];
                float mu = 0.f, rs = 1.f; if constexpr (FOLD) ln_stats(st, row, mu, rs);
#pragma unroll
                for (int n = 0; n < 2; ++n) { f32x4 g = acc[ai][0][m][n], up = acc[ai][1][m][n];
                    if constexpr (!PRE) { g = g * ascale; up = up * ascale; }
                    if constexpr (FOLD) { g = (g - cg[n] * mu) * rs + dg[n]; up = (up - cu[n] * mu) * rs + du[n]; }
                    if constexpr (!PRE) up = up * oscale;
#pragma unroll
                    for (int j = 0; j < 4; ++j) { const float e = __builtin_amdgcn_exp2f(g[j] * -1.4426950408889634f); r[n][j] = g[j] * __builtin_amdgcn_rcpf(1.0f + e) * up[j]; } }
                if constexpr (F8OUT) *(u32x2*)((unsigned char*)O + (size_t)row * ldc + col0) = pack8fp8(r[0], r[1]);
                else *(u32x4*)((bf16_t*)O + (size_t)row * ldc + col0) = pack8bf(r[0], r[1]); }
    }
};
struct EpiBf16 {
    static constexpr bool PERM = true;
    bf16_t* O; int ldc; int rowoff; size_t bufstride; float ascale;
    float f8;
    __device__ __forceinline__ void operator()(EPI_ARGS) const {
        const int row0 = u.pm * BM + wr * 64 + fr, col0 = u.pn * BM + wc * 32 + 8 * fq;
#pragma unroll
        for (int ai = 0; ai < 2; ++ai)
#pragma unroll
            for (int m = 0; m < 4; ++m) { const size_t eo = (size_t)u.buf * bufstride + (size_t)(row0 - rowoff + ai * HALF + m * 16) * ldc + col0;
                if (f8 < 0.f) { const float s8 = ascale * -f8;
#pragma unroll
                    for (int bj = 0; bj < 2; ++bj) { u32x2 w = pack8i8(acc[ai][bj][m][0] * s8, acc[ai][bj][m][1] * s8); w.x ^= 0x80808080u; w.y ^= 0x80808080u; *(u32x2*)((unsigned char*)O + eo + bj * HALF) = w; } }
                else if (f8 != 0.f) { const float s8 = ascale * f8;
#pragma unroll
                    for (int bj = 0; bj < 2; ++bj) *(u32x2*)((unsigned char*)O + eo + bj * HALF) = pack8fp8(acc[ai][bj][m][0] * s8, acc[ai][bj][m][1] * s8); }
                else {
#pragma unroll
                for (int bj = 0; bj < 2; ++bj) *(u32x4*)(O + eo + bj * HALF) = pack8bf(acc[ai][bj][m][0] * ascale, acc[ai][bj][m][1] * ascale); } }
    }
};
struct EpiMlaDown {
    static constexpr bool PERM = true;
    bf16_t* CQ; bf16_t* CKV; bf16_t* KPE; float* ssq; const float* cs; const float* sn; const float* st; const float* C; const float* D;
    float lsc;
    __device__ __forceinline__ float qscale(const Unit&) const { return 1.0f; }
    __device__ __forceinline__ void operator()(EPI_ARGS) const {
        const int row0 = u.pm * BM + wr * 64 + fr, n0 = u.pn * BM + wc * 32 + 8 * fq;
        if (u.pn < 4) {
            bf16_t* dst = (u.pn < 2) ? CQ : CKV; const int col0 = (u.pn & 1) * BM + wc * 32 + 8 * fq; const int slot = (u.pn >> 1) * 8 + (u.pn & 1) * 4 + wc;
            f32x4 cc[2][2], dd[2][2];
#pragma unroll
            for (int bj = 0; bj < 2; ++bj)
#pragma unroll
                for (int n = 0; n < 2; ++n) { cc[bj][n] = *(const f32x4*)(C + n0 + bj * HALF + 4 * n); dd[bj][n] = *(const f32x4*)(D + n0 + bj * HALF + 4 * n); }
#pragma unroll
            for (int ai = 0; ai < 2; ++ai)
#pragma unroll
                for (int m = 0; m < 4; ++m) { const int row = row0 + ai * HALF + m * 16; float s = 0.f; float mu, rs; ln_stats(st, row, mu, rs);
#pragma unroll
                    for (int bj = 0; bj < 2; ++bj) { const f32x4 a = (acc[ai][bj][m][0] - cc[bj][0] * mu) * rs + dd[bj][0], b = (acc[ai][bj][m][1] - cc[bj][1] * mu) * rs + dd[bj][1];
                        s += (a[0] * a[0] + a[1] * a[1]) + (a[2] * a[2] + a[3] * a[3]) + (b[0] * b[0] + b[1] * b[1]) + (b[2] * b[2] + b[3] * b[3]);
                        *(u32x2*)((unsigned char*)dst + (size_t)row * 512 + col0 + bj * HALF) = pack8i8(a * lsc, b * lsc); }
                    s += __shfl_xor(s, 16); s += __shfl_xor(s, 32);
                    if (fq == 0) ssq[(size_t)row * 16 + slot] = s; }
        } else if (wc < 2) {
            const int fi = 16 * wc + 4 * fq;
            const f32x4 c0 = *(const f32x4*)(C + n0), c1 = *(const f32x4*)(C + n0 + 4), d0 = *(const f32x4*)(D + n0), d1 = *(const f32x4*)(D + n0 + 4);
#pragma unroll
            for (int ai = 0; ai < 2; ++ai)
#pragma unroll
                for (int m = 0; m < 4; ++m) { const int row = row0 + ai * HALF + m * 16; float mu, rs; ln_stats(st, row, mu, rs);
                    const f32x4 c4 = *(const f32x4*)(cs + (size_t)row * 32 + fi), s4 = *(const f32x4*)(sn + (size_t)row * 32 + fi);
                    const f32x4 v0 = (acc[ai][0][m][0] - c0 * mu) * rs + d0, v1 = (acc[ai][0][m][1] - c1 * mu) * rs + d1;
                    *(u32x2*)((unsigned char*)KPE + (size_t)row * 64 + 32 * (fq & 1) + 8 * (2 * wc + (fq >> 1))) = pack8fp8(v0 * c4 - v1 * s4, v1 * c4 + v0 * s4); }
        }
    }
};
struct EpiKpe {
    static constexpr bool PERM = true;
    bf16_t* KPE; const float* cs; const float* sn; const float* st; const float* C; const float* D;
    __device__ __forceinline__ float qscale(const Unit&) const { return 1.0f; }
    __device__ __forceinline__ void operator()(EPI_ARGS) const {
        if (wc >= 2) return;
        const int row0 = u.pm * BM + wr * 64 + fr, n0 = 1024 + wc * 32 + 8 * fq, fi = 16 * wc + 4 * fq;
        const f32x4 c0 = *(const f32x4*)(C + n0), c1 = *(const f32x4*)(C + n0 + 4), d0 = *(const f32x4*)(D + n0), d1 = *(const f32x4*)(D + n0 + 4);
#pragma unroll
        for (int ai = 0; ai < 2; ++ai)
#pragma unroll
            for (int m = 0; m < 4; ++m) { const int row = row0 + ai * HALF + m * 16; float mu, rs; ln_stats(st, row, mu, rs);
                const f32x4 c4 = *(const f32x4*)(cs + (size_t)row * 32 + fi), s4 = *(const f32x4*)(sn + (size_t)row * 32 + fi);
                const f32x4 v0 = (acc[ai][0][m][0] - c0 * mu) * rs + d0, v1 = (acc[ai][0][m][1] - c1 * mu) * rs + d1;
                *(u32x2*)((unsigned char*)KPE + (size_t)row * 64 + 32 * (fq & 1) + 8 * (2 * wc + (fq >> 1))) = pack8fp8(v0 * c4 - v1 * s4, v1 * c4 + v0 * s4); }
    }
};
__device__ __forceinline__ float rms_scale(const float* ssq, int row, int which) {
    const f32x4 a = *(const f32x4*)(ssq + (size_t)row * 16 + which * 8), b = *(const f32x4*)(ssq + (size_t)row * 16 + which * 8 + 4);
    const float s = ((a[0] + a[1]) + (a[2] + a[3])) + ((b[0] + b[1]) + (b[2] + b[3]));
    return 1.0f / sqrtf(s * (1.0f / 512.0f) + RMS_EPS);
}
struct EpiMlaQ {
    static constexpr bool PERM = true;
    bf16_t* Q; const float* ssq; const float* cs; const float* sn;
    __device__ __forceinline__ float qscale(const Unit&) const { return 1.0f; }
    __device__ __forceinline__ void operator()(EPI_ARGS) const {
        const int row0 = u.pm * BM + wr * 64 + fr;
#pragma unroll
        for (int ai = 0; ai < 2; ++ai)
#pragma unroll
            for (int m = 0; m < 4; ++m) { const int row = row0 + ai * HALF + m * 16; const float rs = rms_scale(ssq, row, 0);
                if (u.pn < 8) {
#pragma unroll
                    for (int bj = 0; bj < 2; ++bj) { const int h = 2 * u.pn + bj;
                        *(u32x4*)(Q + ((size_t)h * NTOK + row) * 192 + 32 * wc + 8 * fq) = pack8bf(acc[ai][bj][m][0] * rs, acc[ai][bj][m][1] * rs); }
                } else { const int fi = 16 * (wc & 1) + 4 * fq;
                    const f32x4 c4 = *(const f32x4*)(cs + (size_t)row * 32 + fi), s4 = *(const f32x4*)(sn + (size_t)row * 32 + fi);
#pragma unroll
                    for (int bj = 0; bj < 2; ++bj) { const int h = 4 * (u.pn - 8) + 2 * bj + (wc >> 1); const f32x4 v0 = acc[ai][bj][m][0] * rs, v1 = acc[ai][bj][m][1] * rs;
                        *(u32x4*)(Q + ((size_t)h * NTOK + row) * 192 + 128 + 32 * (wc & 1) + 8 * fq) = pack8bf(v0 * c4 - v1 * s4, v1 * c4 + v0 * s4); } }
            }
    }
};
struct EpiMlaKV {
    static constexpr bool PERM = true;
    bf16_t* KN; bf16_t* V; const float* ssq;
    __device__ __forceinline__ float qscale(const Unit& u) const { return u.pn >= 8 ? 0.5f : 1.0f; }
    __device__ __forceinline__ void operator()(EPI_ARGS) const {
        const int row0 = u.pm * BM + wr * 64 + fr; bf16_t* dst = (u.pn < 8) ? KN : V; const int h0 = 2 * (u.pn & 7);
#pragma unroll
        for (int ai = 0; ai < 2; ++ai)
#pragma unroll
            for (int m = 0; m < 4; ++m) { const int row = row0 + ai * HALF + m * 16; const float rs = rms_scale(ssq, row, 1);
#pragma unroll
                for (int bj = 0; bj < 2; ++bj)
                    *(u32x2*)((unsigned char*)dst + ((size_t)(h0 + bj) * NTOK + row) * 128 + 64 * (wc >> 1) + 32 * (fq & 1) + 8 * ((2 * wc + (fq >> 1)) & 3)) = pack8fp8(acc[ai][bj][m][0] * rs, acc[ai][bj][m][1] * rs); }
    }
};
struct EpiMlaVT {
    static constexpr bool PERM = true;
    unsigned char* VT; const float* ssq; float osc;
    __device__ __forceinline__ float qscale(const Unit&) const { return 1.0f; }
    __device__ __forceinline__ void operator()(EPI_ARGS) const {
        const int dcol = 32 * wc + 8 * (fr >> 2) + (fr & 3);
#pragma unroll
        for (int ai = 0; ai < 2; ++ai)
#pragma unroll
            for (int m = 0; m < 4; ++m) { const int t0 = u.pm * BM + ai * HALF + wr * 64 + 16 * m + 4 * fq, q = 4 * m + fq;
                const f32x4 rs = (f32x4){rms_scale(ssq, t0, 1), rms_scale(ssq, t0 + 1, 1), rms_scale(ssq, t0 + 2, 1), rms_scale(ssq, t0 + 3, 1)} * osc;
                const size_t tpos = (size_t)(t0 & ~63) + 32 * (q & 1) + 16 * (q >> 3) + 4 * ((q >> 1) & 3);
#pragma unroll
                for (int bj = 0; bj < 2; ++bj)
#pragma unroll
                    for (int n = 0; n < 2; ++n) { const f32x4 v = acc[ai][bj][m][n] * rs;
                        int w = __builtin_amdgcn_cvt_pk_fp8_f32(clamp448(v[0]), clamp448(v[1]), 0, false); w = __builtin_amdgcn_cvt_pk_fp8_f32(clamp448(v[2]), clamp448(v[3]), w, true);
                        *(unsigned*)(VT + ((size_t)((2 * u.pn + bj) * 128 + dcol + 4 * n)) * NTOK + tpos) = (unsigned)w; } }
    }
};
}
namespace att {
constexpr int NW = 8, QBLK = 32, KVBLK = 64, QB = NW * QBLK, D = 128;
constexpr int SHM_V = KVBLK * D * 2, SHM_K = KVBLK * D * 2, KP_PITCH = 144, SHM_KP = KVBLK * KP_PITCH;
constexpr int OFF_V = 0, OFF_K = 2 * SHM_V, OFF_WS = OFF_K + 2 * SHM_K, OFF_KP = OFF_WS + NW * 64 * 4, OFF_CUM = OFF_KP + 2 * SHM_KP, OFF_QPE = OFF_CUM  , LDS_BYTES = OFF_QPE + 49152;
template <int MODE> struct Cfg;
template <> struct Cfg<0> { static constexpr bool F8PV = false; static constexpr float THR = 8.f; static constexpr bool F8QK = false; static constexpr int NQR = 8; static constexpr int DK = 128; static constexpr bool BIAS = true,  SK = false, KP = false; static constexpr float SCALE = 0.08838834764831845f; };
template <> struct Cfg<1> { static constexpr bool F8PV = false; static constexpr float THR = 8.f; static constexpr bool F8QK = false; static constexpr int NQR = 8; static constexpr int DK = 128; static constexpr bool BIAS = false, SK = true,  KP = false; static constexpr float SCALE = 0.08838834764831845f; };
template <> struct Cfg<2> { static constexpr bool F8PV = true;  static constexpr float THR = 6.f; static constexpr bool F8QK = true;  static constexpr int NQR = 6; static constexpr int DK = 192; static constexpr bool BIAS = false, SK = false, KP = true;  static constexpr float SCALE = 0.07216878364870323f; };

#define KSWZ(row, colB) ((row) * 256 + ((colB) ^ (((row) & 7) << 4)))
#define SBAR() __builtin_amdgcn_sched_barrier(0)
__device__ __forceinline__ int v_st(int k, int c) { const int kk = (k & ~0xC) | ((k & 4) << 1) | ((k & 8) >> 1); return ((kk >> 3) * 4 + (c >> 5)) * 512 + ((kk & 7) * 32 + (c & 31)) * 2; }
__device__ __forceinline__ int v_rd_base(int lane) { return ((lane & 3) << 3) | (((lane >> 2) & 3) << 6) | (((lane >> 4) & 1) << 5) | (((lane >> 5) & 1) << 8); }
constexpr int v_rd_off(int d0, int ks, int half) { return d0 * 512 + ks * 4096 + half * 2048; }
__device__ __forceinline__ int crow(int r, int hi) { return (r & 3) + 8 * (r >> 2) + 4 * hi; }
__device__ __forceinline__ bf16x8 load8(const bf16_t* p) { return *reinterpret_cast<const bf16x8*>(p); }
typedef int v8i_t __attribute__((ext_vector_type(8)));
constexpr int K8P = 208;
__device__ __forceinline__ u32x2 bf8_to_fp8(const bf16x8 v, const float f = 1.0f) {
    const u32x4 w = __builtin_bit_cast(u32x4, v);
    int lo = __builtin_amdgcn_cvt_pk_fp8_f32(__uint_as_float(w[0] << 16) * f, __uint_as_float(w[0] & 0xffff0000u) * f, 0, false); lo = __builtin_amdgcn_cvt_pk_fp8_f32(__uint_as_float(w[1] << 16) * f, __uint_as_float(w[1] & 0xffff0000u) * f, lo, true);
    int hi = __builtin_amdgcn_cvt_pk_fp8_f32(__uint_as_float(w[2] << 16) * f, __uint_as_float(w[2] & 0xffff0000u) * f, 0, false); hi = __builtin_amdgcn_cvt_pk_fp8_f32(__uint_as_float(w[3] << 16) * f, __uint_as_float(w[3] & 0xffff0000u) * f, hi, true);
    return (u32x2){(unsigned)lo, (unsigned)hi}; }

__device__ __forceinline__ void mask_tile(f32x16& p0, f32x16& p1, int dq, unsigned W) {
    const float NEG = -__builtin_inff();
#pragma unroll
    for (int r = 0; r < 16; ++r) {
        const int c = (r & 3) + 8 * (r >> 2);
        if ((unsigned)(dq - c) >= W) p0[r] = NEG;
        if ((unsigned)(dq - c - 32) >= W) p1[r] = NEG;
    }
}
template <int MODE>
__device__ __forceinline__ void partialSM(f32x16& p0, f32x16& p1, float& m_reg, float& mn, float& alpha, const bool first) {
    constexpr float SCALE = Cfg<MODE>::SCALE;
    if constexpr (Cfg<MODE>::F8QK) {
        float pmax = p0[0]; for (int r = 1; r < 16; ++r) pmax = fmaxf(pmax, p0[r]); for (int r = 0; r < 16; ++r) pmax = fmaxf(pmax, p1[r]);
        { auto rr = __builtin_amdgcn_permlane32_swap(__float_as_uint(pmax), __float_as_uint(pmax), false, false);
          pmax = fmaxf(__uint_as_float(rr[0]), __uint_as_float(rr[1])); }
        constexpr float THR2 = Cfg<MODE>::THR * 1.4426950408889634f;
        if (__builtin_expect(!first && __all(pmax <= THR2), 1)) { mn = m_reg; alpha = 1.f; }
        else { const float moff = first ? 0.f : m_reg; mn = fmaxf(m_reg, moff + pmax); alpha = __builtin_amdgcn_exp2f(m_reg - mn); m_reg = mn; const float d = mn - moff;
            for (int r = 0; r < 16; ++r) p0[r] -= d; for (int r = 0; r < 16; ++r) p1[r] -= d; }
        for (int r = 0; r < 16; ++r) p0[r] = __builtin_amdgcn_exp2f(p0[r]);
        return; }
    float pmax = p0[0]; for (int r = 1; r < 16; ++r) pmax = fmaxf(pmax, p0[r]); for (int r = 0; r < 16; ++r) pmax = fmaxf(pmax, p1[r]);
    { auto rr = __builtin_amdgcn_permlane32_swap(__float_as_uint(pmax), __float_as_uint(pmax), false, false);
      pmax = fmaxf(__uint_as_float(rr[0]), __uint_as_float(rr[1])); }
    constexpr float C2 = 1.4426950408889634f * SCALE;
    if (__builtin_expect(__all((pmax - m_reg) * SCALE <= Cfg<MODE>::THR), 1)) { mn = m_reg; alpha = 1.f; }
    else { mn = fmaxf(m_reg, pmax); alpha = __builtin_amdgcn_exp2f((m_reg - mn) * C2); m_reg = mn; }
    const float mnL = -mn * C2;
    for (int r = 0; r < 16; ++r) p0[r] = fmaf(p0[r], C2, mnL); for (int r = 0; r < 16; ++r) p1[r] = fmaf(p1[r], C2, mnL);
    for (int r = 0; r < 16; ++r) p0[r] = __builtin_amdgcn_exp2f(p0[r]);
}
__device__ __forceinline__ void finishSM(f32x16& p0, f32x16& p1, float alpha, float& l_reg, bf16x8& pa0, bf16x8& pa1, bf16x8& pa2, bf16x8& pa3) {
    for (int r = 0; r < 16; ++r) p1[r] = __builtin_amdgcn_exp2f(p1[r]);
    float ps = 0; for (int r = 0; r < 16; ++r) ps += p0[r]; for (int r = 0; r < 16; ++r) ps += p1[r];
    { auto rr = __builtin_amdgcn_permlane32_swap(__float_as_uint(ps), __float_as_uint(ps), false, false);
      ps = __uint_as_float(rr[0]) + __uint_as_float(rr[1]); }
    l_reg = l_reg * alpha + ps;
#define PK4(P, B_, OUT) do { unsigned a0 = cvt_pk_bf16(P[B_+0], P[B_+1]), a1 = cvt_pk_bf16(P[B_+2], P[B_+3]);                          \
        unsigned b0 = cvt_pk_bf16(P[B_+4], P[B_+5]), b1 = cvt_pk_bf16(P[B_+6], P[B_+7]);                                             \
        auto r0 = __builtin_amdgcn_permlane32_swap(a0, b0, false, false); auto r1 = __builtin_amdgcn_permlane32_swap(a1, b1, false, false); \
        u32x4 w = {r0[0], r1[0], r0[1], r1[1]}; OUT = *reinterpret_cast<bf16x8*>(&w); } while (0)
    PK4(p0, 0, pa0); PK4(p0, 8, pa1); PK4(p1, 0, pa2); PK4(p1, 8, pa3);
#undef PK4
}
constexpr int VP8 = 80;
__device__ __forceinline__ void finishSM8(f32x16& p0, f32x16& p1, float alpha, float& l_reg, v8i_t& pf) {
    for (int r = 0; r < 16; ++r) p1[r] = __builtin_amdgcn_exp2f(p1[r]);
    float ps = 0; for (int r = 0; r < 16; ++r) ps += p0[r]; for (int r = 0; r < 16; ++r) ps += p1[r];
    { auto rr = __builtin_amdgcn_permlane32_swap(__float_as_uint(ps), __float_as_uint(ps), false, false);
      ps = __uint_as_float(rr[0]) + __uint_as_float(rr[1]); }
    l_reg = l_reg * alpha + ps;
#pragma unroll
    for (int j = 0; j < 4; ++j) { int w = __builtin_amdgcn_cvt_pk_fp8_f32(p0[4 * j], p0[4 * j + 1], 0, false); w = __builtin_amdgcn_cvt_pk_fp8_f32(p0[4 * j + 2], p0[4 * j + 3], w, true); pf[j] = w;
        int x = __builtin_amdgcn_cvt_pk_fp8_f32(p1[4 * j], p1[4 * j + 1], 0, false); x = __builtin_amdgcn_cvt_pk_fp8_f32(p1[4 * j + 2], p1[4 * j + 3], x, true); pf[4 + j] = x; }
}
__device__ __forceinline__ void pv_tile8(f32x16* o, const char* vrt, int r32, int hi, const v8i_t pf) {
    const char* vb = vrt + r32 * VP8 + hi * 32; const int sc1 = 0x7F7F7F7F;
#pragma unroll
    for (int d0 = 0; d0 < 4; ++d0) { const u32x4 a0 = *reinterpret_cast<const u32x4*>(vb + d0 * 32 * VP8), a1 = *reinterpret_cast<const u32x4*>(vb + d0 * 32 * VP8 + 16);
        const v8i_t vf = (v8i_t){(int)a0[0], (int)a0[1], (int)a0[2], (int)a0[3], (int)a1[0], (int)a1[1], (int)a1[2], (int)a1[3]};
        asm volatile("v_mfma_scale_f32_32x32x64_f8f6f4 %0, %1, %2, %0, %3, %3 op_sel_hi:[0,0,0]" : "+v"(o[d0]) : "v"(pf), "v"(vf), "v"(sc1)); }
}
template <int MODE, int KB, bool PAD = false>
__device__ __forceinline__ void qkt(f32x16& p0, f32x16& p1, const char* K_lds, const char* KP_lds, int r32, int hi, const bf16x8* qr, const v8i_t* q8, bool act, const float* ck, float cq, const char* qpe, const float minit, const char* krt = nullptr) {
    constexpr bool SK = Cfg<MODE>::SK;
    if constexpr (Cfg<MODE>::F8QK) {
        const float ni_ = -minit; const int sc1 = 0x7F7F7F7F, scq = 0x7C7C7C7C;
#pragma unroll
        for (int r = 0; r < 16; ++r) { p0[r] = ni_; p1[r] = ni_; }
        const char* k0 = krt + r32 * K8P + hi * 32;
#pragma unroll
        for (int s = 0; s < 3; ++s) {
            const u32x4 a0 = *reinterpret_cast<const u32x4*>(k0 + 64 * s), a1 = *reinterpret_cast<const u32x4*>(k0 + 64 * s + 16);
            const u32x4 b0 = *reinterpret_cast<const u32x4*>(k0 + 32 * K8P + 64 * s), b1 = *reinterpret_cast<const u32x4*>(k0 + 32 * K8P + 64 * s + 16);
            const v8i_t ka = (v8i_t){(int)a0[0], (int)a0[1], (int)a0[2], (int)a0[3], (int)a1[0], (int)a1[1], (int)a1[2], (int)a1[3]}, kb2 = (v8i_t){(int)b0[0], (int)b0[1], (int)b0[2], (int)b0[3], (int)b1[0], (int)b1[1], (int)b1[2], (int)b1[3]};
            asm volatile("v_mfma_scale_f32_32x32x64_f8f6f4 %0, %1, %2, %0, %3, %4 op_sel_hi:[0,0,0]" : "+v"(p0) : "v"(ka), "v"(q8[s]), "v"(sc1), "v"(scq));
            asm volatile("v_mfma_scale_f32_32x32x64_f8f6f4 %0, %1, %2, %0, %3, %4 op_sel_hi:[0,0,0]" : "+v"(p1) : "v"(kb2), "v"(q8[s]), "v"(sc1), "v"(scq)); }
        if constexpr (PAD) asm volatile("s_nop 15\n\ts_nop 15" : "+v"(p0), "+v"(p1));
        return; }
    if (SK && !act) { const float NEG = -__builtin_inff();
#pragma unroll
        for (int r = 0; r < 16; ++r) { p0[r] = NEG; p1[r] = NEG; } return; }
    if constexpr (Cfg<MODE>::BIAS) {
        const f32x4* c4 = reinterpret_cast<const f32x4*>(ck + 4 * hi);
#pragma unroll
        for (int g = 0; g < 4; ++g) { const f32x4 a = c4[2 * g], b = c4[2 * g + 8];
#pragma unroll
            for (int j = 0; j < 4; ++j) { p0[4 * g + j] = a[j]; p1[4 * g + j] = b[j]; } }
    } else { p0 = f32x16{}; p1 = f32x16{}; }
    const char* kb[4];
#pragma unroll
    for (int dd = 0; dd < 4; ++dd) kb[dd] = K_lds + KB * SHM_K + KSWZ(r32, (dd * 16 + hi * 8) * 2);
#pragma unroll
    for (int d0 = 0; d0 < 8; ++d0) { const char* a = kb[d0 & 3] + (d0 >> 2) * 128;
        bf16x8 b0 = *reinterpret_cast<const bf16x8*>(a);
        bf16x8 b1 = *reinterpret_cast<const bf16x8*>(a + 32 * 256);
        bf16x8 qf; if (d0 < Cfg<MODE>::NQR) qf = qr[d0]; else qf = *reinterpret_cast<const bf16x8*>(qpe + (d0 - Cfg<MODE>::NQR) * 1024);
        p0 = __builtin_amdgcn_mfma_f32_32x32x16_bf16(b0, qf, p0, 0, 0, 0);
        p1 = __builtin_amdgcn_mfma_f32_32x32x16_bf16(b1, qf, p1, 0, 0, 0); }
    if constexpr (Cfg<MODE>::KP) {
        const char* kp = KP_lds + KB * SHM_KP + r32 * KP_PITCH + hi * 16;
#pragma unroll
        for (int j = 0; j < 4; ++j) {
            bf16x8 b0 = *reinterpret_cast<const bf16x8*>(kp + j * 32);
            bf16x8 b1 = *reinterpret_cast<const bf16x8*>(kp + j * 32 + 32 * KP_PITCH);
            const bf16x8 qf = *reinterpret_cast<const bf16x8*>(qpe + (8 - Cfg<MODE>::NQR + j) * 1024);
            p0 = __builtin_amdgcn_mfma_f32_32x32x16_bf16(b0, qf, p0, 0, 0, 0);
            p1 = __builtin_amdgcn_mfma_f32_32x32x16_bf16(b1, qf, p1, 0, 0, 0); }
    }
}
template <int VB, bool SK>
__device__ __forceinline__ void pv_tile(f32x16* o, int vb0, bf16x8 pa0, bf16x8 pa1, bf16x8 pa2, bf16x8 pa3, bool act) {
    if (SK && !act) return;
#define TRRD(dst, off) asm volatile("ds_read_b64_tr_b16 %0, %1 offset:%2" : "=&v"(dst) : "v"(vb0), "i"(off) : "memory")
#define PV_D0(d0) do { s16x4 l0, l1, l2, l3, h0, h1, h2, h3; constexpr int b_ = OFF_V + VB * SHM_V + v_rd_off(d0, 0, 0); \
        TRRD(l0, b_); TRRD(h0, b_ + 2048); TRRD(l1, b_ + 4096); TRRD(h1, b_ + 6144); TRRD(l2, b_ + 8192); TRRD(h2, b_ + 10240); TRRD(l3, b_ + 12288); TRRD(h3, b_ + 14336); \
        asm volatile("s_waitcnt lgkmcnt(0)" ::: "memory"); SBAR();   \
        o[d0] = __builtin_amdgcn_mfma_f32_32x32x16_bf16(pa0, (bf16x8){l0[0], l0[1], l0[2], l0[3], h0[0], h0[1], h0[2], h0[3]}, o[d0], 0, 0, 0);   \
        o[d0] = __builtin_amdgcn_mfma_f32_32x32x16_bf16(pa1, (bf16x8){l1[0], l1[1], l1[2], l1[3], h1[0], h1[1], h1[2], h1[3]}, o[d0], 0, 0, 0);   \
        o[d0] = __builtin_amdgcn_mfma_f32_32x32x16_bf16(pa2, (bf16x8){l2[0], l2[1], l2[2], l2[3], h2[0], h2[1], h2[2], h2[3]}, o[d0], 0, 0, 0);   \
        o[d0] = __builtin_amdgcn_mfma_f32_32x32x16_bf16(pa3, (bf16x8){l3[0], l3[1], l3[2], l3[3], h3[0], h3[1], h3[2], h3[3]}, o[d0], 0, 0, 0); } while (0)
    PV_D0(0); PV_D0(1); PV_D0(2); PV_D0(3);
#undef PV_D0
#undef TRRD
}

struct BlockRef { int qrow, kvrow, kprow, orow, hcol, P0, jlo; float m0, l0; };
struct AttnArgs { const bf16_t* Q; const bf16_t* K; const bf16_t* V; const bf16_t* KP; bf16_t* O; const float* cum; const float* sinks; int nh, nhkv, W, ldo; const float* nrm; float o8 = 0.f; };
template <int MODE> struct Seam { bf16x8 qr[Cfg<MODE>::DK / 16]; bf16x8 st_v0, st_v1, st_k0, st_k1, st_kp; int b0; };
__device__ __forceinline__ int swa_jlo(int P0, int W) { const int lowk = P0 - W + 1; return lowk > 0 ? lowk / KVBLK : 0; }
#define ROW(p, k0, rr) ((p) + (size_t)((k0) + (rr)) * D + sc)
#define VMW() asm volatile("s_waitcnt vmcnt(0)" ::: "memory")
#define VMWN(n) asm volatile("s_waitcnt vmcnt(%0)" :: "i"(n) : "memory")
#define KBASE8(kvrow_) (C::F8QK ? (const bf16_t*)((const char*)a.K + (size_t)(kvrow_) * 128) : a.K + (size_t)(kvrow_) * D)
#define KPBASE8(kprow_) (C::F8QK ? (const bf16_t*)((const char*)a.KP + (size_t)(kprow_) * 64) : a.KP + (size_t)(kprow_) * 64)
#define VBASE(kvrow_, kprow_) (C::F8PV ? (const bf16_t*)((const char*)a.V + (size_t)((kvrow_) - (kprow_)) * 128 + (kprow_)) : a.V + (size_t)(kvrow_) * D)
#define SLOAD_H(Kp, Vp, KPp, k0) do { if constexpr (C::F8PV) { S.st_v0 = *(const bf16x8*)((const char*)(Vp) + (size_t)(2 * kr + (kc >> 2)) * NTOK + (k0) + 16 * (kc & 3)); }       \
                         else { S.st_v0 = load8(ROW(Vp, k0, sr)); S.st_v1 = load8(ROW(Vp, k0, 32 + sr)); }             \
                         if constexpr (C::F8QK) { S.st_k0 = *(const bf16x8*)((const char*)(Kp) + (size_t)((k0) + kr) * 128 + kc * 16);                                         \
                             if (kr < 32) S.st_kp = *(const bf16x8*)((const char*)(KPp) + (size_t)((k0) + 2 * kr + (kc >> 2)) * 64 + (kc & 3) * 16); }                          \
                         else { S.st_k0 = load8(ROW(Kp, k0, sr)); S.st_k1 = load8(ROW(Kp, k0, 32 + sr));                  \
                         if constexpr (C::KP) S.st_kp = load8((KPp) + (size_t)((k0) + kr) * 64 + kc * 8); } } while (0)
#define SWRITE_HK(bf) do { if constexpr (C::F8QK) { char* kb_ = K_lds + (bf) * SHM_K;       \
                           *(bf16x8*)(kb_ + kr * K8P + kc * 16) = S.st_k0; if (kr < 32) *(bf16x8*)(kb_ + (2 * kr + (kc >> 2)) * K8P + 128 + (kc & 3) * 16) = S.st_kp; } else {     \
                         *(bf16x8*)(K_lds + (bf) * SHM_K + kws) = S.st_k0; *(bf16x8*)(K_lds + (bf) * SHM_K + kws + 32 * 256) = S.st_k1; \
                         if constexpr (C::KP) *(bf16x8*)(KP_lds + (bf) * SHM_KP + kr * KP_PITCH + kc * 16) = S.st_kp; } } while (0)
#define SWRITE_HV(bf) do { if constexpr (C::F8PV) { *(bf16x8*)(V_lds + (bf) * SHM_V + (2 * kr + (kc >> 2)) * VP8 + (kc & 3) * 16) = S.st_v0; }                                   \
                         else { *(bf16x8*)(V_lds + (bf) * SHM_V + vst0) = S.st_v0; *(bf16x8*)(V_lds + (bf) * SHM_V + vst1) = S.st_v1; } } while (0)
#define SWRITE_H(bf) do { SWRITE_HV(bf); SWRITE_HK(bf); } while (0)
template <int MODE>
__device__ __forceinline__ void attn_prime(const AttnArgs& a, const BlockRef& cur, char* lds, Seam<MODE>& S, const int tid) {
    const int W = a.W;
    using C = Cfg<MODE>; constexpr int NQ = C::DK / 16;
    const int wid = __builtin_amdgcn_readfirstlane(tid >> 6), lane = tid & 63, r32 = lane & 31, hi = lane >> 5;
    const int sr = tid >> 4, sc = (tid & 15) * 8, kws = KSWZ(sr, sc * 2), kr = tid >> 3, kc = tid & 7; char* K_lds = lds + OFF_K; char* KP_lds = lds + OFF_KP;
    const int kb0 = cur.jlo * KVBLK; (void)W;
#pragma unroll
    for (int d0 = 0; d0 < NQ; ++d0) S.qr[d0] = load8(a.Q + (size_t)(cur.qrow + wid * QBLK + r32) * C::DK + d0 * 16 + hi * 8);
    SLOAD_H(KBASE8(cur.kvrow), VBASE(cur.kvrow, cur.kprow), KPBASE8(cur.kprow), kb0); VMW(); SWRITE_HK(0); S.b0 = 0;
    __syncthreads();
}
template <int MODE>
__device__ __forceinline__ void attn_block(const AttnArgs& a, const BlockRef& cur, const BlockRef& nxt, char* lds, Seam<MODE>& S, const int tid) {
    const int W = a.W, ldo = a.ldo;
    using C = Cfg<MODE>; constexpr int NQ = C::DK / 16; constexpr bool SK = C::SK; constexpr int NQR = C::NQR;
    const int wid = __builtin_amdgcn_readfirstlane(tid >> 6), lane = tid & 63, r32 = lane & 31, hi = lane >> 5;
    const int j_lo = cur.jlo;
    const int j_hi = (cur.P0 + QB - 1) / KVBLK + 1;
    const int NT = j_hi - j_lo;
    const int kbn = nxt.jlo * KVBLK;
    const int qlo = cur.P0 + wid * QBLK, qm = qlo + r32 - 4 * hi;
    char* V_lds = lds + OFF_V; char* K_lds = lds + OFF_K; char* KP_lds = lds + OFF_KP;
    float* ws = (float*)(lds + OFF_WS) + wid * 64; float* li_l = ws, * al_l = ws + 32;
    const float* cum_l = (const float*)(lds + OFF_CUM);
    char* qpe = lds + OFF_QPE + wid * 6144 + lane * 16;
    v8i_t q8[3];
    if constexpr (C::F8QK) {
        constexpr float QF = 8.0f * 1.4426950408889634f * C::SCALE;
#pragma unroll
        for (int s = 0; s < 3; ++s) { const u32x2 c0 = bf8_to_fp8(S.qr[4 * s], QF), c1 = bf8_to_fp8(S.qr[4 * s + 1], QF), c2 = bf8_to_fp8(S.qr[4 * s + 2], QF), c3 = bf8_to_fp8(S.qr[4 * s + 3], QF);
            q8[s] = (v8i_t){(int)c0.x, (int)c0.y, (int)c1.x, (int)c1.y, (int)c2.x, (int)c2.y, (int)c3.x, (int)c3.y}; } }
    else if constexpr (NQR < NQ) {
#pragma unroll
        for (int j = NQR; j < NQ; ++j) *(bf16x8*)(qpe + (j - NQR) * 1024) = S.qr[j]; }
    float m_reg = cur.m0, l_reg = cur.l0; f32x16 o[4] = {};
    const float cq = 0.f;
    const int sr = tid >> 4, sc = (tid & 15) * 8, vst0 = v_st(sr, sc), vst1 = v_st(32 + sr, sc), kws = KSWZ(sr, sc * 2), kr = tid >> 3, kc = tid & 7;
    const int vb0 = (int)(uintptr_t)lds + v_rd_base(lane);
    const bf16_t* Kh = KBASE8(cur.kvrow); const bf16_t* Vh = VBASE(cur.kvrow, cur.kprow); const bf16_t* KPh = KPBASE8(cur.kprow);
#define RESC(a) do { if (__any((a) < 1.f)) { if (hi == 0) al_l[r32] = (a); asm volatile("s_waitcnt lgkmcnt(0)" ::: "memory");              \
                     for (int d_ = 0; d_ < 4; ++d_) for (int r = 0; r < 16; ++r) o[d_][r] *= al_l[crow(r, hi)]; } } while (0)
#define KBASE(t) ((j_lo + (t)) * KVBLK)
#define ACT(t) (KBASE(t) <= qlo + QBLK - 1 && KBASE(t) + KVBLK - 1 >= qlo - W + 1)
#define MASKT(P0_, P1_, t) do { const int kb_ = KBASE(t); if ((!SK || ACT(t)) && (kb_ + KVBLK - 1 > qlo || kb_ <= qlo + QBLK - 1 - W)) mask_tile(P0_, P1_, qm - kb_, (unsigned)W); } while (0)
#define QKT(KB_, PX0, PX1, t) qkt<MODE, KB_>(PX0, PX1, K_lds, KP_lds, r32, hi, S.qr, q8, ACT(t), cum_l + KBASE(t), cq, qpe, m_reg, KB3(bq))
#define SEAM_K0() do { VMWN(NQR); if constexpr (C::F8QK) { const int nb_ = ((NT & 1) == 0) ? NX3(bq) : bq; char* kb_ = KB3(nb_);     \
                           *(bf16x8*)(kb_ + kr * K8P + kc * 16) = S.st_k0; if (kr < 32) *(bf16x8*)(kb_ + (2 * kr + (kc >> 2)) * K8P + 128 + (kc & 3) * 16) = S.st_kp; S.b0 = nb_; }  \
                       else SWRITE_HK(0); SBAR(); } while (0)
    f32x16 pA0, pA1, pB0, pB1; float mnA, mnB, alA, alB; bf16x8 pa0, pa1, pa2, pa3; v8i_t pf8;
    int bq = S.b0;
#define KB3(i) (lds + ((i) == 0 ? OFF_K : ((i) == 1 ? OFF_K + SHM_K : OFF_QPE)))
#define VB3(i) (lds + ((i) == 0 ? OFF_V : ((i) == 1 ? OFF_V + SHM_V : OFF_QPE + 16384)))
#define NX3(i) ((i) == 2 ? 0 : (i) + 1)
#define PR3(i) ((i) == 0 ? 2 : (i) - 1)
#define SWRITE3(i) do { char* kb_ = KB3(i); char* vb_ = VB3(i); *(bf16x8*)(vb_ + (2 * kr + (kc >> 2)) * VP8 + (kc & 3) * 16) = S.st_v0;                             \
                       *(bf16x8*)(kb_ + kr * K8P + kc * 16) = S.st_k0; if (kr < 32) *(bf16x8*)(kb_ + (2 * kr + (kc >> 2)) * K8P + 128 + (kc & 3) * 16) = S.st_kp; } while (0)
#define FIN(PY0, PY1, alY) do { if constexpr (C::F8PV) finishSM8(PY0, PY1, alY, l_reg, pf8); else finishSM(PY0, PY1, alY, l_reg, pa0, pa1, pa2, pa3); } while (0)
#define PV(VB_, act_) do { if constexpr (C::F8PV) pv_tile8(o, (VB_) == 0 ? VB3(PR3(bq)) : VB3(bq), r32, hi, pf8); else pv_tile<VB_, SK>(o, vb0, pa0, pa1, pa2, pa3, act_); } while (0)
#define PVPREV(VB_, act_) do { if constexpr (C::F8PV) pv_tile8(o, VB3(PR3(bq)), r32, hi, pf8); else pv_tile<VB_, SK>(o, vb0, pa0, pa1, pa2, pa3, act_); } while (0)
    if constexpr (C::F8PV) { *(bf16x8*)(VB3(bq) + (2 * kr + (kc >> 2)) * VP8 + (kc & 3) * 16) = S.st_v0; } else SWRITE_HV(0);
    SBAR();
    if (NT > 1) { SLOAD_H(Kh, Vh, KPh, KBASE(1)); }
    SBAR(); qkt<MODE, 0, true>(pA0, pA1, K_lds, KP_lds, r32, hi, S.qr, q8, ACT(0), cum_l + KBASE(0), cq, qpe, 0.f, KB3(bq));
    MASKT(pA0, pA1, 0); partialSM<MODE>(pA0, pA1, m_reg, mnA, alA, true);
    if (NT > 1) { VMW(); if constexpr (C::F8QK) SWRITE3(NX3(bq)); else SWRITE_H(1); }
    if constexpr (C::F8QK) bq = NX3(bq);
    __syncthreads();
#define HALF_STEP(PX0, PX1, mnX, alX, PY0, PY1, alY, t, KB, VB, SB) do {                                                      \
        SBAR(); QKT(KB, PX0, PX1, t);                                                                                         \
        FIN(PY0, PY1, alY); SBAR();                                                                                           \
        if ((t) + 1 < NT) { SLOAD_H(Kh, Vh, KPh, KBASE((t) + 1)); SBAR(); }                                                   \
        PVPREV(VB, ACT((t) - 1)); MASKT(PX0, PX1, (t)); partialSM<MODE>(PX0, PX1, m_reg, mnX, alX, false);                    \
        if constexpr (!C::F8QK) __syncthreads();                                                                              \
        if ((t) + 1 < NT) { VMW(); if constexpr (C::F8QK) SWRITE3(NX3(bq)); else SWRITE_H(SB); }                              \
        if constexpr (C::F8QK) bq = NX3(bq);                                                                                  \
        RESC(alX); __syncthreads(); } while (0)
    for (int t = 1; t + 1 < NT; t += 2) {
        HALF_STEP(pB0, pB1, mnB, alB, pA0, pA1, alA, t, 1, 0, 0);
        HALF_STEP(pA0, pA1, mnA, alA, pB0, pB1, alB, t + 1, 0, 1, 1);
    }
    {
    int lane_t; asm volatile("v_mbcnt_lo_u32_b32 %0, -1, 0\n\tv_mbcnt_hi_u32_b32 %0, -1, %0" : "=v"(lane_t));
    const int lane = lane_t, r32 = lane & 31, hi = lane >> 5, tid_t = wid * 64 + lane, sr = tid_t >> 4, sc = (tid_t & 15) * 8, kws = KSWZ(sr, sc * 2), kr = tid_t >> 3, kc = tid_t & 7;
    const int qm = qlo + r32 - 4 * hi; (void)kr; (void)kc;
    const bool even = (NT & 1) == 0;
    if (even) { SBAR(); QKT(1, pB0, pB1, NT - 1); SBAR(); }
    int nq_ = nxt.qrow, nkv_ = nxt.kvrow, nkp_ = nxt.kprow, kbn_ = kbn;
    asm volatile("" : "+s"(nq_), "+s"(nkv_), "+s"(nkp_), "+s"(kbn_));
    SLOAD_H(KBASE8(nkv_), VBASE(nkv_, nkp_), KPBASE8(nkp_), kbn_); SBAR();
#pragma unroll
    for (int d0 = 0; d0 < NQR; ++d0) S.qr[d0] = load8(a.Q + (size_t)(nq_ + wid * QBLK + r32) * C::DK + d0 * 16 + hi * 8);
    SBAR();
    FIN(pA0, pA1, alA); SBAR();
    PV(0, ACT(even ? NT - 2 : NT - 1));
    if (even) { MASKT(pB0, pB1, NT - 1); partialSM<MODE>(pB0, pB1, m_reg, mnB, alB, false); __syncthreads(); RESC(alB);
        FIN(pB0, pB1, alB); SBAR(); PV(1, ACT(NT - 1)); }
    if constexpr (C::F8PV) asm volatile("s_nop 15\n\ts_nop 15" : "+v"(o[0]), "+v"(o[1]), "+v"(o[2]), "+v"(o[3]));
    SBAR(); SEAM_K0();
    if constexpr (NQR < NQ) {
#pragma unroll
        for (int d0 = NQR; d0 < NQ; ++d0) S.qr[d0] = load8(a.Q + (size_t)(nq_ + wid * QBLK + r32) * C::DK + d0 * 16 + hi * 8);
        SBAR(); }
    if (hi == 0) li_l[r32] = l_reg; asm volatile("s_waitcnt lgkmcnt(0)" ::: "memory");
    float rli[16];
#pragma unroll
    for (int r = 0; r < 16; ++r) rli[r] = __builtin_amdgcn_rcpf(li_l[crow(r, hi)]) * (C::F8PV ? 0.125f : 1.0f);
    int orow_ = cur.orow, hcol_ = cur.hcol; asm volatile("" : "+s"(orow_), "+s"(hcol_));
    if (a.o8 != 0.f) {
        unsigned char* Ob = (unsigned char*)a.O + (size_t)(orow_ + wid * QBLK) * ldo + hcol_; const float os = a.o8;
#pragma unroll
        for (int r = 0; r < 16; ++r) { const int orow = crow(r, hi);
#pragma unroll
            for (int d0 = 0; d0 < 4; ++d0) { const float v = __builtin_amdgcn_fmed3f(o[d0][r] * rli[r] * os, -448.f, 448.f);
                const float vn = __shfl_xor(v, 1);
                const int pk = __builtin_amdgcn_cvt_pk_fp8_f32(v, vn, 0, false) & 0xffff; const int pk2 = __shfl_xor(pk, 2);
                if ((r32 & 3) == 0) *(unsigned*)(Ob + (size_t)orow * ldo + d0 * 32 + r32) = (unsigned)pk | ((unsigned)pk2 << 16); } }
    } else {
    bf16_t* Ow = a.O + (size_t)(orow_ + wid * QBLK) * ldo + hcol_;
#pragma unroll
    for (int r = 0; r < 16; ++r) { const int orow = crow(r, hi);
#pragma unroll
        for (int d0 = 0; d0 < 4; ++d0) { const float v = o[d0][r] * rli[r];
            const float vn = __shfl_xor(v, 1);
            if ((r32 & 1) == 0) *(unsigned*)(Ow + (size_t)orow * ldo + d0 * 32 + r32) = cvt_pk_bf16(v, vn); } }
    }
    __syncthreads();
    }
#undef RESC
#undef KBASE
#undef ACT
#undef MASKT
#undef QKT
#undef SEAM_K0
#undef KB3
#undef VB3
#undef NX3
#undef PR3
#undef SWRITE3
#undef PVPREV
#undef HALF_STEP
#undef FIN
#undef PV
}
#undef ROW
#undef VMW
#undef VMWN
#undef SLOAD_H
#undef VBASE
#undef KBASE8
#undef KPBASE8
#undef SWRITE_HK
#undef SWRITE_HV
#undef SWRITE_H

__device__ inline int swa_nramp(int nqb, int W) { const int t = W - 1; const int n = t < 0 ? 0 : t / QB + 1; return n > nqb ? nqb : n; }
struct SwaItem { int bh, qb0, qb1; };
__device__ __forceinline__ SwaItem swa_decode(int L, int nqb, int nx, int nramp) {
    SwaItem it; it.bh = L / nx; const int x = L - it.bh * nx; const int ns = nqb - nramp;
    if (x < ns) { it.qb0 = it.qb1 = nqb - 1 - x; } else { it.qb0 = x - ns; it.qb1 = nramp - 1 - it.qb0; }
    return it;
}
template <int MODE>
__device__ __forceinline__ BlockRef make_ref(const AttnArgs& a, const SwaItem& it, int pass, int jskip0 = 0, int jskip1 = 0) {
    const int qb = pass ? it.qb1 : it.qb0, b = it.bh / a.nh, h = it.bh - b * a.nh, kvh = h / (a.nh / a.nhkv);
    BlockRef r;
    r.qrow = h * NTOK + b * SEQ + qb * QB; r.kvrow = kvh * NTOK + b * SEQ; r.kprow = b * SEQ; r.orow = b * SEQ + qb * QB; r.hcol = h * D; r.P0 = qb * QB;
    r.jlo = (MODE == 0) ? (pass ? jskip1 : jskip0) : swa_jlo(r.P0, a.W);
    if (MODE == 1) { r.m0 = a.sinks[h] * (1.0f / Cfg<MODE>::SCALE); r.l0 = 1.f; } else { r.m0 = -1e30f; r.l0 = 0.f; }
    return r;
}
template <int MODE>
__device__ __forceinline__ void attn_phase(char* lds, const AttnArgs& a, int G, int c, const int tid) {
    constexpr int nqb = SEQ / QB;
    const int nramp = swa_nramp(nqb, a.W), nx = (nramp + 1) / 2 + (nqb - nramp), total = nx * NBATCH * a.nh;
    int L = c; if (L >= total) return;
    const int wv = __builtin_amdgcn_readfirstlane(tid >> 6); (void)wv;
    SwaItem it = swa_decode(L, nqb, nx, nramp); int pass = 0; int cum_bh = -1; int js0 = 0, js1 = 0;
    if constexpr (Cfg<MODE>::BIAS) {
        { const f32x4* src = (const f32x4*)(a.cum + (size_t)it.bh * SEQ); f32x4* dst = (f32x4*)(lds + OFF_CUM); dst[tid] = src[tid]; dst[tid + 512] = src[tid + 512]; cum_bh = it.bh; }
        float* red = (float*)(lds + OFF_WS);
        const int b = it.bh / a.nh, h = it.bh - b * a.nh, lane = tid & 63;
        float km = 0.f;
        { const f32x4* kn = (const f32x4*)(a.nrm + ((size_t)(8 + h) * NTOK + (size_t)b * SEQ) * 4);
#pragma unroll
          for (int i = 0; i < 8; ++i) { const f32x4 v = kn[8 * tid + i]; km = fmaxf(km, (v[0] + v[1]) + (v[2] + v[3])); } }
        const int qbx = (tid < 256) ? it.qb0 : it.qb1;
        float qm; { const f32x4 v = ((const f32x4*)(a.nrm + ((size_t)h * NTOK + (size_t)b * SEQ + (size_t)qbx * QB) * 4))[tid & 255]; qm = (v[0] + v[1]) + (v[2] + v[3]); }
#pragma unroll
        for (int o = 1; o < 64; o <<= 1) { km = fmaxf(km, __shfl_xor(km, o)); qm = fmaxf(qm, __shfl_xor(qm, o)); }
        if (lane == 0) { red[wv] = km; red[8 + wv] = qm; }
        __syncthreads();
        float K2 = 0.f, Q20 = 0.f, Q21 = 0.f;
#pragma unroll
        for (int w = 0; w < 8; ++w) { K2 = fmaxf(K2, red[w]); if (w < 4) Q20 = fmaxf(Q20, red[8 + w]); else Q21 = fmaxf(Q21, red[8 + w]); }
        const float* nc = (const float*)(lds + OFF_CUM); const float Kn = sqrtf(K2);
        const float lim0 = -(32.0f / Cfg<MODE>::SCALE) - 2.04f * sqrtf(Q20) * Kn, lim1 = -(32.0f / Cfg<MODE>::SCALE) - 2.04f * sqrtf(Q21) * Kn;
        const float t00 = nc[it.qb0 * QB], t01 = nc[it.qb1 * QB];
        while (js0 < it.qb0 * (QB / KVBLK) && nc[js0 * KVBLK + KVBLK - 1] - t00 < lim0) ++js0;
        while (js1 < it.qb1 * (QB / KVBLK) && nc[js1 * KVBLK + KVBLK - 1] - t01 < lim1) ++js1;
        js0 = __builtin_amdgcn_readfirstlane(js0); js1 = __builtin_amdgcn_readfirstlane(js1);
        __syncthreads();
    }
    BlockRef cur = make_ref<MODE>(a, it, 0, js0, js1);
    Seam<MODE> S;
    attn_prime<MODE>(a, cur, lds, S, tid);
    bool first_item = true;
    for (;;) {
        if constexpr (Cfg<MODE>::BIAS) { if (it.bh != cum_bh) {
            const f32x4* src = (const f32x4*)(a.cum + (size_t)it.bh * SEQ); f32x4* dst = (f32x4*)(lds + OFF_CUM);
            int l_; asm volatile("v_mbcnt_lo_u32_b32 %0, -1, 0\n\tv_mbcnt_hi_u32_b32 %0, -1, %0" : "=v"(l_)); const int t2 = wv * 64 + l_;
            dst[t2] = src[t2]; dst[t2 + 512] = src[t2 + 512];
            cum_bh = it.bh; __syncthreads(); } }
        const bool more_pass = pass == 0 && it.qb1 != it.qb0, more_item = L + G < total, last = !more_pass && !more_item;
        SwaItem itn = it; int passn = pass + 1, Ln = L;
        if (!more_pass) { passn = 0; Ln = more_item ? L + G : L; itn = swa_decode(Ln, nqb, nx, nramp); }
        const bool nfirst = first_item && more_pass;
        const BlockRef nxt = last ? cur : make_ref<MODE>(a, itn, passn, nfirst ? js0 : 0, nfirst ? js1 : 0);
        attn_block<MODE>(a, cur, nxt, lds, S, tid);
        if (last) break;
        if (!more_pass) first_item = false;
        cur = nxt; it = itn; pass = passn; L = Ln;
    }
}
#undef KSWZ
#undef SBAR
}
constexpr size_t MiB = 1u << 20;
constexpr size_t WS_CTL = 0, CTL_ZERO_BYTES = 64 * 1024;
constexpr size_t WS_LOGF = 1 * MiB;
constexpr size_t WS_CUMF = 1 * MiB + 512 * 1024;
constexpr size_t WS_C128 = 2 * MiB, WS_S128 = 6 * MiB;
constexpr size_t WS_C64 = 10 * MiB, WS_S64 = 12 * MiB;
constexpr size_t WS_SSQ = 14 * MiB;
constexpr size_t WS_RT = 15 * MiB;
constexpr size_t RT_E = 0, RT_G = 128 * 1024, RT_P = 256 * 1024, RT_CNT = 384 * 1024, RT_META = 384 * 1024 + 8192;
constexpr size_t RT_ST1 = 512 * 1024, RT_ST2 = 640 * 1024;
constexpr size_t RT_CGU = 768 * 1024, RT_DGU = 832 * 1024, RT_CIN = 896 * 1024, RT_DIN = 904 * 1024;
constexpr size_t WS_W_IN0 = 16 * MiB, WS_W_OUT0 = 34 * MiB, WS_W_GU0 = 42 * MiB, WS_W_D0 = 86 * MiB, WS_W_IN1 = 108 * MiB, WS_W_UQ = 113 * MiB, WS_W_UKV = 116 * MiB, WS_W_OUT1 = 120 * MiB;
constexpr size_t WS_W_MGU = 128 * MiB, WS_W_MD = 576 * MiB;
constexpr size_t WS_XB = 800 * MiB, WS_QKV0 = 864 * MiB, WS_O0 = 1008 * MiB, WS_Y = 1072 * MiB, WS_H1 = 1200 * MiB, WS_H1B = 1328 * MiB;
constexpr size_t WS_NRM = 1200 * MiB;
constexpr size_t WS_ACT0 = 800 * MiB, WS_H2 = 1392 * MiB, WS_H2B = 1520 * MiB;
constexpr size_t WS_CQ = 1584 * MiB, WS_CKV = 1600 * MiB, WS_KPE = 1616 * MiB;
constexpr size_t WS_Q1 = 800 * MiB, WS_KN1 = 896 * MiB, WS_V1 = 960 * MiB, WS_O1 = 1200 * MiB;
constexpr size_t WS_H3 = 1600 * MiB, WS_H3B = 1728 * MiB;
constexpr size_t WS_Y3B = 1632 * MiB;
constexpr float YM_SC = 400.f;
constexpr size_t WS_XS = 800 * MiB, WS_ACT1 = 1200 * MiB, WS_YM = 1440 * MiB, WS_YM1 = 800 * MiB;
constexpr size_t WS_END = 1760 * MiB;
static_assert(WS_ACT1 + (size_t)MOE_TILES_MAX * 256 * FFE <= WS_YM && WS_YM + (size_t)MOE_TILES_MAX * 256 * DM * 2 <= WS_H3B && WS_ACT1 >= WS_Y + (size_t)NTOK * DM * 4, "moe map (Y stays intact until the last phase)");

constexpr int LDS_BYTES = 147456, LDS_MISC = 147456 - 256;
static_assert(att::LDS_BYTES <= LDS_MISC && pg8::STAGE_BYTES <= LDS_MISC, "LDS map");
constexpr int NPHASE = 15;

struct Params { const float* in[27]; float* out; unsigned char* ws; int ph_lo, ph_hi; int li, pad; double invf128[64]; double invf64[32]; };

__device__ __forceinline__ float wave_sum(float v) {
#pragma unroll
    for (int o = 1; o < 64; o <<= 1) v += __shfl_xor(v, o);
    return v;
}
__device__ __forceinline__ void sincos_dd(double a, float& s, float& c) {
    const double q = rint(a * 0.63661977236758134308);
    double r = fma(-q, 1.57079632679489655800, a); r = fma(-q, 6.12323399573676603587e-17, r);
    const int quad = (int)((long long)q & 3);
    const double r2 = r * r;
    const double sp = r * (1.0 + r2 * (-1.0 / 6 + r2 * (1.0 / 120 + r2 * (-1.0 / 5040 + r2 * (1.0 / 362880 + r2 * (-1.0 / 39916800))))));
    const double cp = 1.0 + r2 * (-0.5 + r2 * (1.0 / 24 + r2 * (-1.0 / 720 + r2 * (1.0 / 40320 + r2 * (-1.0 / 3628800 + r2 * (1.0 / 479001600))))));
    const double sv = (quad & 1) ? cp : sp, cv = (quad & 1) ? sp : cp;
    s = (float)((quad & 2) ? -sv : sv); c = (float)((quad == 1 || quad == 2) ? -cv : cv);
}

constexpr bool FP8_GU0 = true;
constexpr float WSC_I8GU = 2550.f, ASC_YI8 = 19.f;
constexpr float WSC_O = 512.f, ASC_O = 16.f;
constexpr float WSC_I8UP = 640.f, ASC_LI8 = 27.f;
constexpr float WSC_I8IN = 1280.f, ASC_XI8 = 27.f;
constexpr float WSC_DOWN = 1024.f, WSC_GU = 512.f, ASC_ACT = 16.f, ASC_X = 8.f, ASC_Y = 4.f;
struct CvtItem { const float* src; int srcN; bf16_t* dst; int K, n0, k0; int scol; const float* ksc; float f8s; };
__device__ __forceinline__ int rp128(int p) { return ((p >> 2) & 1) * 64 + (p >> 3) * 4; }
__device__ __forceinline__ int rp64(int p) { return ((p >> 2) & 1) * 32 + (p >> 3) * 4; }
__device__ __forceinline__ CvtItem cvt_decode(const Params& P, int it, int tid) {
    CvtItem c; c.ksc = nullptr; c.f8s = 0.f; int kind, nNb; const float* src2 = nullptr; unsigned char* ws = P.ws;
    if (it < 1152) { kind = 1; c.src = P.in[2]; c.srcN = 4616; c.dst = (bf16_t*)(ws + WS_W_IN0); c.K = 2048; nNb = 72; }
    else if ((it -= 1152) < 512) { kind = 0; c.src = P.in[5]; c.srcN = 2048; c.dst = (bf16_t*)(ws + WS_W_OUT0); c.K = 2048; nNb = 32; }
    else if ((it -= 512) < 2816) { kind = 2; c.src = P.in[8]; src2 = P.in[9]; c.srcN = FFD; c.dst = (bf16_t*)(ws + WS_W_GU0); c.K = 2048; nNb = 176; c.f8s = FP8_GU0 ? WSC_GU : 0.f; c.ksc = P.in[6]; }
    else if ((it -= 2816) < 1408) { kind = 0; c.src = P.in[10]; c.srcN = 2048; c.dst = (bf16_t*)(ws + WS_W_D0); c.K = FFD; nNb = 32; c.f8s = WSC_DOWN; }
    else if ((it -= 1408) < 320) { kind = 3; c.src = P.in[13]; c.srcN = 1088; c.dst = (bf16_t*)(ws + WS_W_IN1); c.K = 2048; nNb = 20; c.ksc = P.in[11]; }
    else if ((it -= 320) < 192) { kind = 4; c.src = P.in[15]; c.srcN = 3072; c.dst = (bf16_t*)(ws + WS_W_UQ); c.K = 512; nNb = 48; c.ksc = P.in[14]; }
    else if ((it -= 192) < 256) { kind = 5; c.src = P.in[17]; c.srcN = 4096; c.dst = (bf16_t*)(ws + WS_W_UKV); c.K = 512; nNb = 64; c.ksc = P.in[16]; }
    else if ((it -= 256) < 512) { kind = 0; c.src = P.in[18]; c.srcN = 2048; c.dst = (bf16_t*)(ws + WS_W_OUT1); c.K = 2048; nNb = 32; }
    else if ((it -= 512) < 28672) { const int e = it / 3584; it -= e * 3584; kind = 2; c.src = P.in[22] + (size_t)e * 2048 * FFE; src2 = P.in[23] + (size_t)e * 2048 * FFE; c.srcN = FFE;
        c.dst = (bf16_t*)((unsigned char*)(ws + WS_W_MGU) + (size_t)e * 14336 * 2048); c.K = 2048; nNb = 224; c.f8s = WSC_GU; }
    else { it -= 28672; const int e = it / 1792; it -= e * 1792; kind = 0; c.src = P.in[24] + (size_t)e * FFE * 2048; c.srcN = 2048; c.dst = (bf16_t*)((unsigned char*)(ws + WS_W_MD) + (size_t)e * 2048 * FFE); c.K = FFE; nNb = 32; c.f8s = WSC_DOWN; }
    const int kb = it / nNb, nb = it - kb * nNb; c.k0 = kb * 128; c.n0 = nb * 64;
    const int n = c.n0 + 4 * (tid & 15); int sc = n;
    if (kind == 1) { if (n >= 4352) sc = 4360 + (n - 4352); else if (n >= 4096) sc = 4104 + ((n - 4096) >> 7) * 128 + rp128((n - 4096) & 127); else if (n >= 3072) sc = 3080 + ((n - 3072) >> 7) * 128 + rp128((n - 3072) & 127); }
    else if (kind == 2) { const int t = n >> 8, r = n & 255; if (r < 128) sc = t * 128 + r; else { sc = t * 128 + r - 128; c.src = src2; } }
    else if (kind == 3) { if (n >= 1088) sc = -1; else if (n >= 1024) sc = 1024 + rp64(n - 1024); }
    else if (kind == 4) { if (n < 2048) sc = (n >> 7) * 192 + (n & 127); else sc = ((n - 2048) >> 6) * 192 + 128 + rp64((n - 2048) & 63); }
    else if (kind == 5) { if (n < 2048) sc = (n >> 7) * 256 + (n & 127); else sc = ((n - 2048) >> 7) * 256 + 128 + ((n - 2048) & 127); }
    c.scol = sc; return c;
}
constexpr int CVT_ITEMS = 7168 + 28672 + 14336;
struct CvtMat { const float* src; const float* src2; unsigned char* dst; const float* ksc; float f8s; int srcN, K, nNb, nItems, kind, deal, i8; };
__device__ __forceinline__ CvtMat cvt_matrix(const Params& P, int mi) {
    CvtMat m; m.src2 = nullptr; m.ksc = nullptr; m.f8s = 0.f; m.kind = 0; m.deal = 0; m.i8 = 0; unsigned char* ws = P.ws;
    if (mi >= 16) { const int e = mi - 16; m.src = P.in[24] + (size_t)e * FFE * 2048; m.srcN = 2048; m.dst = ws + WS_W_MD + (size_t)e * 2048 * FFE; m.K = FFE; m.nNb = 32; m.f8s = WSC_DOWN; m.deal = 2; }
    else if (mi >= 8) { const int e = mi - 8; m.kind = 2; m.src = P.in[22] + (size_t)e * 2048 * FFE; m.src2 = P.in[23] + (size_t)e * 2048 * FFE; m.srcN = FFE; m.dst = ws + WS_W_MGU + (size_t)e * 14336 * 2048; m.K = 2048; m.nNb = 224; m.f8s = WSC_I8GU; m.i8 = 1; m.deal = 1; }
    else if (mi == 0) { m.kind = 1; m.src = P.in[2]; m.srcN = 4616; m.dst = ws + WS_W_IN0; m.K = 2048; m.nNb = 72; m.f8s = WSC_I8IN; m.i8 = 1; }
    else if (mi == 1) { m.src = P.in[5]; m.srcN = 2048; m.dst = ws + WS_W_OUT0; m.K = 2048; m.nNb = 32; m.f8s = WSC_O; }
    else if (mi == 2) { m.kind = 2; m.src = P.in[8]; m.src2 = P.in[9]; m.srcN = FFD; m.dst = ws + WS_W_GU0; m.K = 2048; m.nNb = 176; m.f8s = WSC_I8GU; m.i8 = 1; m.ksc = P.in[6]; m.deal = 1; }
    else if (mi == 3) { m.src = P.in[10]; m.srcN = 2048; m.dst = ws + WS_W_D0; m.K = FFD; m.nNb = 32; m.f8s = WSC_DOWN; m.deal = 3; }
    else if (mi == 4) { m.kind = 3; m.src = P.in[13]; m.srcN = 1088; m.dst = ws + WS_W_IN1; m.K = 2048; m.nNb = 20; m.ksc = P.in[11]; m.f8s = WSC_I8IN; m.i8 = 1; }
    else if (mi == 5) { m.kind = 4; m.src = P.in[15]; m.srcN = 3072; m.dst = ws + WS_W_UQ; m.K = 512; m.nNb = 48; m.ksc = P.in[14]; m.f8s = WSC_I8UP; m.i8 = 1; }
    else if (mi == 6) { m.kind = 5; m.src = P.in[17]; m.srcN = 4096; m.dst = ws + WS_W_UKV; m.K = 512; m.nNb = 64; m.ksc = P.in[16]; m.f8s = WSC_I8UP; m.i8 = 1; }
    else { m.src = P.in[18]; m.srcN = 2048; m.dst = ws + WS_W_OUT1; m.K = 2048; m.nNb = 32; m.f8s = WSC_O; }
    m.nItems = (m.K / 128) * m.nNb; return m;
}
struct CvtIter { CvtMat m; int mi, r, kb, nb, stride; };
__device__ __forceinline__ void cvt_kn(const CvtMat& m, int r, int& kb, int& nb) {
    if (m.deal == 1) { const int g = r >> 8, w = r & 255; kb = w & 15; nb = g * 16 + (w >> 4); }
    else if (m.deal == 2) { const int g = r >> 8, w = r & 255; kb = g * 8 + (w & 7); nb = w >> 3; }
    else if (m.deal == 3) { const int g = r >> 7, w = r & 127; kb = g * 4 + (w & 3); nb = w >> 2; }
    else { kb = r / m.nNb; nb = r - kb * m.nNb; }
}
struct CvtDesc { unsigned char* dptr; int K; float f8s; int i8; };
__device__ __forceinline__ void cvt_issue(const Params& P, CvtIter& I, int tid, f32x4 (&v)[4], CvtDesc& d) {
    const int n4 = tid & 15, kk = tid >> 4, n = I.nb * 64 + 4 * n4, k0 = I.kb * 128, kind = I.m.kind;
    const float* s = I.m.src; int sc = n;
    if (kind == 1) { if (n >= 4352) sc = 4360 + (n - 4352); else if (n >= 4096) sc = 4104 + ((n - 4096) >> 7) * 128 + rp128((n - 4096) & 127); else if (n >= 3072) sc = 3080 + ((n - 3072) >> 7) * 128 + rp128((n - 3072) & 127); }
    else if (kind == 2) { const int t = n >> 8, r = n & 255; if (r < 128) sc = t * 128 + r; else { sc = t * 128 + r - 128; s = I.m.src2; } }
    else if (kind == 3) { if (n >= 1088) sc = -1; else if (n >= 1024) sc = 1024 + rp64(n - 1024); }
    else if (kind == 4) { if (n < 2048) sc = (n >> 7) * 192 + (n & 127); else sc = ((n - 2048) >> 6) * 192 + 128 + rp64((n - 2048) & 63); }
    else if (kind == 5) { if (n < 2048) sc = (n >> 7) * 256 + (n & 127); else sc = ((n - 2048) >> 7) * 256 + 128 + ((n - 2048) & 127); }
    d.K = I.m.K; d.f8s = I.m.f8s; d.i8 = I.m.i8; if (kind == 1) { const int n0 = I.nb * 64; if ((n0 >= 2048 && n0 < 3072) || n0 >= 4352) d.f8s *= 2.f; }
    if (kind == 5 && I.nb * 64 >= 2048) d.f8s *= 2.f;
    d.dptr = I.m.dst + ((size_t)(I.nb * 64) * I.m.K + k0) * (I.m.f8s != 0.f ? 1 : 2);
    if (sc >= 0) { const float* p0 = s + (size_t)(k0 + kk) * I.m.srcN + sc; const size_t st = (size_t)32 * I.m.srcN;
#pragma unroll
        for (int p = 0; p < 4; ++p) v[p] = __builtin_nontemporal_load((const f32x4*)(p0 + p * st)); }
    else {
#pragma unroll
        for (int p = 0; p < 4; ++p) v[p] = (f32x4){0.f, 0.f, 0.f, 0.f}; }
    if (I.m.ksc) {
#pragma unroll
        for (int p = 0; p < 4; ++p) v[p] = v[p] * I.m.ksc[k0 + kk + 32 * p]; }
    I.r += I.stride;
    while (I.mi < 24 && I.r >= I.m.nItems) { I.r -= I.m.nItems; ++I.mi; if (I.mi < 24) I.m = cvt_matrix(P, I.mi); }
    cvt_kn(I.m, I.r, I.kb, I.nb);
}
constexpr int CVT_P2 = 68;
__device__ __forceinline__ void cvt_to_lds2(LAS float* scr, int tid, const f32x4 (&v)[4]) {
    const int n4 = tid & 15, kk = tid >> 4;
#pragma unroll
    for (int p = 0; p < 4; ++p) { const int k = kk + 32 * p; *(LAS f32x4*)(scr + k * CVT_P2 + 4 * (n4 ^ ((k >> 4) & 7))) = v[p]; }
}
__device__ __forceinline__ void cvt_store2(const LAS float* scr, int tid, const CvtDesc& d) {
    if (d.f8s != 0.f) {
        const int ch = tid & 7, n = tid >> 3; const LAS float* s = scr + (16 * ch) * CVT_P2 + (n ^ (4 * ch)); float t[16];
#pragma unroll
        for (int j = 0; j < 16; ++j) t[j] = s[j * CVT_P2] * d.f8s;
        const f32x4 t0 = (f32x4){t[0], t[1], t[2], t[3]}, t1 = (f32x4){t[4], t[5], t[6], t[7]}, t2 = (f32x4){t[8], t[9], t[10], t[11]}, t3 = (f32x4){t[12], t[13], t[14], t[15]};
        const u32x2 a = d.i8 ? pg8::pack8i8(t0, t1) : pg8::pack8fp8(t0, t1), b = d.i8 ? pg8::pack8i8(t2, t3) : pg8::pack8fp8(t2, t3);
        __builtin_nontemporal_store((u32x4){a.x, a.y, b.x, b.y}, (u32x4*)(d.dptr + (size_t)n * d.K + 16 * ch));
        return; }
    const int ch = tid & 15;
#pragma unroll
    for (int q = 0; q < 2; ++q) { const int n = (tid >> 4) + 32 * q; const LAS float* s = scr + (8 * ch) * CVT_P2 + (n ^ (4 * (ch >> 1)));
        u32x4 w; w.x = cvt_pk_bf16(s[0], s[CVT_P2]); w.y = cvt_pk_bf16(s[2 * CVT_P2], s[3 * CVT_P2]); w.z = cvt_pk_bf16(s[4 * CVT_P2], s[5 * CVT_P2]); w.w = cvt_pk_bf16(s[6 * CVT_P2], s[7 * CVT_P2]);
        *(u32x4*)(d.dptr + ((size_t)n * d.K + 8 * ch) * 2) = w; }
}
__device__ __forceinline__ void p0_convert(const Params& P, LAS unsigned char* lds, const int tid, const int first, const int stride, const int end) {
    LAS float* scrA = (LAS float*)lds; LAS float* scrB = (LAS float*)(lds + 34816);
    if (first >= end) return; const int cnt = (end - first + stride - 1) / stride;
    CvtIter I; { int base = 0, mi = 0; for (;; ++mi) { I.m = cvt_matrix(P, mi); if (first < base + I.m.nItems) break; base += I.m.nItems; }
        I.mi = mi; I.r = first - base; I.stride = stride; cvt_kn(I.m, I.r, I.kb, I.nb); }
    CvtDesc d0, d1, d2, d3; f32x4 v0[4], v1[4], v2[4], v3[4]; d1 = d2 = d3 = CvtDesc{nullptr, 0, 0.f, 0};
    cvt_issue(P, I, tid, v0, d0);
    if (cnt > 1) cvt_issue(P, I, tid, v1, d1);
    if (cnt > 2) cvt_issue(P, I, tid, v2, d2);
    if (cnt > 3) cvt_issue(P, I, tid, v3, d3);
    int i = 0;
#define CVT_STAGE(v, d, scr) { if (i >= cnt) break; cvt_to_lds2(scr, tid, v); __syncthreads(); const CvtDesc o_ = d; if (i + 4 < cnt) cvt_issue(P, I, tid, v, d); cvt_store2(scr, tid, o_); ++i; }
    for (;;) { CVT_STAGE(v0, d0, scrA) CVT_STAGE(v1, d1, scrB) CVT_STAGE(v2, d2, scrA) CVT_STAGE(v3, d3, scrB) }
#undef CVT_STAGE
    __syncthreads();
}
__device__ __forceinline__ void p0_colsums(const Params& P, LAS unsigned char* lds, const int tid) {
    LAS f32x4* red = (LAS f32x4*)lds;
    for (int s = blockIdx.x; s < 176 + 20; s += gridDim.x) {
        const bool gu = s < 176; const int it = gu ? (1152 + 512 + s) : (1152 + 512 + 2816 + 1408 + (s - 176));
        const CvtItem c = cvt_decode(P, it, tid); const float* gv = c.ksc; const float* bv = gu ? P.in[7] : P.in[12];
        const int n4 = tid & 15, kk = tid >> 4; f32x4 ag = (f32x4){0.f, 0.f, 0.f, 0.f}, ab = ag;
        if (c.scol >= 0) {
#pragma unroll 16
            for (int k = kk; k < 2048; k += 32) { const f32x4 w = *(const f32x4*)(c.src + (size_t)k * c.srcN + c.scol); ag = ag + w * gv[k]; ab = ab + w * bv[k]; } }
        red[(kk * 16 + n4) * 2] = ag; red[(kk * 16 + n4) * 2 + 1] = ab;
        __syncthreads();
        if (tid < 16) { f32x4 sg = (f32x4){0.f, 0.f, 0.f, 0.f}, sb = sg;
            for (int q = 0; q < 32; ++q) { sg = sg + red[(q * 16 + tid) * 2]; sb = sb + red[(q * 16 + tid) * 2 + 1]; }
            float* Cv = (float*)(P.ws + WS_RT + (gu ? RT_CGU : RT_CIN)); float* Dv = (float*)(P.ws + WS_RT + (gu ? RT_DGU : RT_DIN)); const int n = c.n0 + 4 * tid;
            *(f32x4*)(Cv + n) = sg; *(f32x4*)(Dv + n) = sb; }
        __syncthreads();
    }
}
__device__ __forceinline__ void colsums_q(const Params& P, const int tid, const int w0, const int nw) {
    const int lane = tid & 63, wave = tid >> 6;
    for (int mat = 0; mat < 2; ++mat) {
        const signed char* Wq = (const signed char*)(P.ws + (mat == 0 ? WS_W_GU0 : WS_W_IN1)); const int nrows = mat == 0 ? 2 * FFD : 1280;
        const float* gv = mat == 0 ? P.in[6] : P.in[11]; const float* bv = mat == 0 ? P.in[7] : P.in[12]; const float inv = 1.0f / (mat == 0 ? WSC_I8GU : WSC_I8IN);
        float* Cv = (float*)(P.ws + WS_RT + (mat == 0 ? RT_CGU : RT_CIN)); float* Dv = (float*)(P.ws + WS_RT + (mat == 0 ? RT_DGU : RT_DIN));
        float ratio[32];
#pragma unroll
        for (int i = 0; i < 8; ++i) { const f32x4 g4 = *(const f32x4*)(gv + 32 * lane + 4 * i), b4 = *(const f32x4*)(bv + 32 * lane + 4 * i);
#pragma unroll
            for (int j = 0; j < 4; ++j) ratio[4 * i + j] = b4[j] / g4[j]; }
        for (int n = w0 * 8 + wave; n < nrows; n += nw * 8) {
            const u32x4 a = *(const u32x4*)(Wq + (size_t)n * 2048 + 32 * lane), b = *(const u32x4*)(Wq + (size_t)n * 2048 + 32 * lane + 16);
            float sc = 0.f, sd = 0.f;
#pragma unroll
            for (int i = 0; i < 8; ++i) { const unsigned w = i < 4 ? a[i] : b[i - 4];
#pragma unroll
                for (int j = 0; j < 4; ++j) { const float v = (float)((int)(w << (24 - 8 * j)) >> 24); sc += v; sd = fmaf(v, ratio[4 * i + j], sd); } }
            sc = wave_sum(sc); sd = wave_sum(sd);
            if (lane == 0) { Cv[n] = sc * inv; Dv[n] = sd * inv; }
        }
    }
}
__device__ __forceinline__ void xprep_row(const f32x4 (&v)[8], const int m, LAS float* wf, bf16_t* XB, float* LOGF, const float* bfg, const int lane) {
        unsigned* o4 = (unsigned*)((unsigned char*)XB + (size_t)m * DM) + lane;
#pragma unroll
        for (int j = 0; j < 8; ++j) o4[64 * j] = pg8::pack4i8(v[j] * ASC_XI8);
        float f[8];
#pragma unroll
        for (int e = 0; e < 8; ++e) { float s = 0.f;
#pragma unroll
            for (int j = 0; j < 8; ++j) { const f32x4 w = *(const LAS f32x4*)(wf + e * 2048 + 256 * j + 4 * lane); s = fmaf(v[j][0], w[0], s); s = fmaf(v[j][1], w[1], s); s = fmaf(v[j][2], w[2], s); s = fmaf(v[j][3], w[3], s); }
            f[e] = wave_sum(s); }
        if (lane < 8) { float z = 0.f;
#pragma unroll
            for (int e = 0; e < 8; ++e) z = (lane == e) ? f[e] : z;
            z += bfg[lane];
            LOGF[(size_t)m * 8 + lane] = fminf(z, 0.f) - log1pf(expf(-fabsf(z))); }
}
__device__ __forceinline__ void p0_xprep(const Params& P, LAS unsigned char* lds, const int tid) {
    const int lane = tid & 63, wave = tid >> 6, G = gridDim.x;
    LAS float* wf = (LAS float*)(lds + 69632);
    { float* st = (float*)(P.ws + WS_RT + RT_ST1); for (int i = blockIdx.x * 512 + tid; i < NTOK * 4; i += gridDim.x * 512) st[i] = 0.f; }
    const float* w_in0 = P.in[2];
    for (int idx = tid; idx < 16384; idx += 512) { const int k = idx >> 3, e = idx & 7; wf[e * 2048 + k] = w_in0[(size_t)k * 4616 + 3072 + e]; }
    __syncthreads();
    const float* x = P.in[0]; bf16_t* XB = (bf16_t*)(P.ws + WS_XB); float* LOGF = (float*)(P.ws + WS_LOGF); const float* bfg = P.in[3];
    { const int step = G * 8; int m = blockIdx.x * 8 + wave; f32x4 va[8], vb[8];
#define XP_LOAD(v, mm) { const f32x4* xr_ = (const f32x4*)(x + (size_t)(mm) * DM) + lane; _Pragma("unroll") for (int j = 0; j < 8; ++j) v[j] = __builtin_nontemporal_load(xr_ + 64 * j); }
      if (m < NTOK) XP_LOAD(va, m)
      while (m < NTOK) {
        asm volatile("" ::: "memory");
        if (m + step < NTOK) XP_LOAD(vb, m + step)
        xprep_row(va, m, wf, XB, LOGF, bfg, lane);
        m += step; if (m >= NTOK) break;
        asm volatile("" ::: "memory");
        if (m + step < NTOK) XP_LOAD(va, m + step)
        xprep_row(vb, m, wf, XB, LOGF, bfg, lane);
        m += step; }
#undef XP_LOAD
    }
    const int* pos = (const int*)P.in[1];
    float* C128 = (float*)(P.ws + WS_C128); float* S128 = (float*)(P.ws + WS_S128); float* C64 = (float*)(P.ws + WS_C64); float* S64 = (float*)(P.ws + WS_S64);
    for (int idx = blockIdx.x * 512 + tid; idx < NTOK * 64; idx += G * 512) { const int m = idx >> 6, i = idx & 63; float s, c; sincos_dd((double)pos[m] * P.invf128[i], s, c); C128[idx] = c; S128[idx] = s; }
    for (int idx = blockIdx.x * 512 + tid; idx < NTOK * 32; idx += G * 512) { const int m = idx >> 5, i = idx & 31; float s, c; sincos_dd((double)pos[m] * P.invf64[i], s, c); C64[idx] = c; S64[idx] = s; }
}
__device__ __forceinline__ void p1_cumsum(const Params& P, LAS unsigned char* lds, const int tid) {
    const int lane = tid & 63, wave = tid >> 6;
    LAS double* wt = (LAS double*)lds;
    for (int w = blockIdx.x; w < 32; w += gridDim.x) {
        const int b = w >> 3, h = w & 7; const float* LOGF = (const float*)(P.ws + WS_LOGF);
        double e[8]; double s = 0.0;
#pragma unroll
        for (int i = 0; i < 8; ++i) { s += (double)LOGF[((size_t)b * SEQ + 8 * tid + i) * 8 + h]; e[i] = s; }
        double inc = s;
#pragma unroll
        for (int o = 1; o < 64; o <<= 1) { const double t = __shfl_up(inc, o); if (lane >= o) inc += t; }
        if (lane == 63) wt[wave] = inc;
        __syncthreads();
        double base = inc - s;
        for (int k = 0; k < wave; ++k) base += wt[k];
        float* out = (float*)(P.ws + WS_CUMF) + (size_t)w * SEQ + 8 * tid;
#pragma unroll
        for (int i = 0; i < 8; ++i) out[i] = (float)((base + e[i]) * -11.313708498984761);
        __syncthreads();
    }
}

__device__ __forceinline__ void ln_norm2(f32x4 (&v)[8], const float* g, const float* b, int lane, float& mean_o, float& rstd_o) {
    float s = 0.f;
#pragma unroll
    for (int j = 0; j < 8; ++j) s += (v[j][0] + v[j][1]) + (v[j][2] + v[j][3]);
    const float mean = wave_sum(s) * (1.f / DM); float s2 = 0.f;
#pragma unroll
    for (int j = 0; j < 8; ++j) { v[j] = v[j] - mean; s2 += (v[j][0] * v[j][0] + v[j][1] * v[j][1]) + (v[j][2] * v[j][2] + v[j][3] * v[j][3]); }
    const float rstd = 1.f / sqrtf(wave_sum(s2) * (1.f / DM) + LN_EPS);
#pragma unroll
    for (int j = 0; j < 8; ++j) { const f32x4 gv = *((const f32x4*)g + lane + 64 * j), bv = *((const f32x4*)b + lane + 64 * j); v[j] = v[j] * rstd * gv + bv; }
    mean_o = mean; rstd_o = rstd;
}
__device__ __forceinline__ void ln_norm(f32x4 (&v)[8], const float* g, const float* b, int lane) { float m_, r_; ln_norm2(v, g, b, lane, m_, r_); }
__device__ __forceinline__ void ln_store(const f32x4 (&v)[8], float* hf, bf16_t* hb, size_t m, int lane, float f8s = 0.f) {
    if (hf) { f32x4* o = (f32x4*)(hf + m * DM) + lane;
#pragma unroll
        for (int j = 0; j < 8; ++j) __builtin_nontemporal_store(v[j], o + 64 * j); }
    if (hb && f8s != 0.f) { unsigned* o4 = (unsigned*)((unsigned char*)hb + m * DM) + lane;
#pragma unroll
        for (int j = 0; j < 8; ++j) { if (f8s < 0.f) { o4[64 * j] = pg8::pack4i8(v[j] * -f8s); continue; }
            const f32x4 t = v[j] * f8s; int w = __builtin_amdgcn_cvt_pk_fp8_f32(pg8::clamp448(t[0]), pg8::clamp448(t[1]), 0, false); w = __builtin_amdgcn_cvt_pk_fp8_f32(pg8::clamp448(t[2]), pg8::clamp448(t[3]), w, true); o4[64 * j] = (unsigned)w; } }
    else if (hb) { u32x2* o8 = (u32x2*)(hb + m * DM) + lane;
#pragma unroll
        for (int j = 0; j < 8; ++j) { u32x2 w; w.x = cvt_pk_bf16(v[j][0], v[j][1]); w.y = cvt_pk_bf16(v[j][2], v[j][3]); o8[64 * j] = w; } }
}
__device__ __forceinline__ f32x4 bf4x(const u32x2 a) { return (f32x4){__uint_as_float(a.x << 16), __uint_as_float(a.x & 0xffff0000u), __uint_as_float(a.y << 16), __uint_as_float(a.y & 0xffff0000u)}; }
__device__ __forceinline__ void ln3_router_phase(const Params& P, LAS unsigned char* lds, const int tid) {
    const int lane = tid & 63, wave = tid >> 6;
    LAS float* wr = (LAS float*)lds;
    LAS int* wcnt = (LAS int*)(lds + 65536);
    const float* w_router = P.in[21];
    for (int idx = tid; idx < 16384; idx += 512) { const int k = idx >> 3, e = idx & 7; wr[e * 2048 + k] = w_router[idx]; }
    __syncthreads();
    const bf16_t* Y = (const bf16_t*)(P.ws + WS_Y3B); bf16_t* H3B = (bf16_t*)(P.ws + WS_H3B); float* st3 = (float*)(P.ws + WS_RT + RT_ST1);
    int* rte = (int*)(P.ws + WS_RT + RT_E); float* rtg = (float*)(P.ws + WS_RT + RT_G); int* cntblk = (int*)(P.ws + WS_RT + RT_CNT);
    for (int c = blockIdx.x; c < NTOK / 64; c += gridDim.x) {
        int cnt[8];
#pragma unroll
        for (int e = 0; e < 8; ++e) cnt[e] = 0;
#pragma unroll 1
        for (int i = 0; i < 8; ++i) { const int m = c * 64 + wave * 8 + i; asm volatile("" ::: "memory");
            const u32x2* yr = (const u32x2*)(Y + (size_t)m * DM) + lane; f32x4 v[8];
#pragma unroll
            for (int j = 0; j < 8; ++j) v[j] = bf4x(yr[64 * j]);
            float mu3, rs3; ln_norm2(v, P.in[19], P.in[20], lane, mu3, rs3); ln_store(v, nullptr, H3B, (size_t)m, lane, -ASC_XI8);
            if (lane == 0) { st3[2 * m] = mu3; st3[2 * m + 1] = rs3; }
            float l[8];
#pragma unroll
            for (int e = 0; e < 8; ++e) { float s = 0.f;
#pragma unroll
                for (int j = 0; j < 8; ++j) { const f32x4 w = *(const LAS f32x4*)(wr + e * 2048 + 256 * j + 4 * lane); s = fmaf(v[j][0], w[0], s); s = fmaf(v[j][1], w[1], s); s = fmaf(v[j][2], w[2], s); s = fmaf(v[j][3], w[3], s); }
                l[e] = wave_sum(s); }
            float v1 = l[0]; int e1 = 0;
#pragma unroll
            for (int e = 1; e < 8; ++e) if (l[e] > v1) { v1 = l[e]; e1 = e; }
            float v2 = -__builtin_inff(); int e2 = 0;
#pragma unroll
            for (int e = 0; e < 8; ++e) if (e != e1 && l[e] > v2) { v2 = l[e]; e2 = e; }
            const float ex = expf(v2 - v1), g1 = 1.0f / (1.0f + ex), g2 = ex / (1.0f + ex);
            if (lane == 0) { rte[2 * m] = e1; rte[2 * m + 1] = e2; rtg[2 * m] = g1; rtg[2 * m + 1] = g2; }
#pragma unroll
            for (int e = 0; e < 8; ++e) cnt[e] += (e1 == e) + (e2 == e);
        }
        if (lane == 0) {
#pragma unroll
            for (int e = 0; e < 8; ++e) wcnt[wave * 8 + e] = cnt[e]; }
        __syncthreads();
        if (tid < 8) { int s = 0;
#pragma unroll
            for (int w = 0; w < 8; ++w) s += wcnt[w * 8 + tid];
            cntblk[c * 8 + tid] = s; }
        __syncthreads();
    }
}
__device__ __forceinline__ void perm_phase(const Params& P, LAS unsigned char* lds, const int tid) {
    const int lane = tid & 63, wave = tid >> 6;
    LAS int* pre = (LAS int*)lds;
    LAS int* tot = (LAS int*)(lds + 8192);
    LAS int* pst = (LAS int*)(lds + 8192 + 64);
    LAS int* posl = (LAS int*)(lds + 8192 + 128);
    const int* cntblk = (const int*)(P.ws + WS_RT + RT_CNT); int* meta = (int*)(P.ws + WS_RT + RT_META);
    { const int e = wave; int cv[4]; int s = 0;
#pragma unroll
      for (int i = 0; i < 4; ++i) { cv[i] = cntblk[(4 * lane + i) * 8 + e]; s += cv[i]; }
      int inc = s;
#pragma unroll
      for (int o = 1; o < 64; o <<= 1) { const int t = __shfl_up(inc, o); if (lane >= o) inc += t; }
      int ex = inc - s;
#pragma unroll
      for (int i = 0; i < 4; ++i) { pre[(4 * lane + i) * 8 + e] = ex; ex += cv[i]; }
      if (lane == 63) tot[e] = inc; }
    __syncthreads();
    if (tid == 0) { int ps = 0;
        for (int e = 0; e < 8; ++e) { pst[e] = ps; if (blockIdx.x == 0) meta[1 + e] = ps >> 8; ps += ((tot[e] + 255) >> 8) << 8; }
        if (blockIdx.x == 0) { meta[0] = ps >> 8; meta[9] = ps >> 8; } }
    __syncthreads();
    const int* rte = (const int*)(P.ws + WS_RT + RT_E); int* rtp = (int*)(P.ws + WS_RT + RT_P);
    const bf16_t* H3B = (const bf16_t*)(P.ws + WS_H3B); unsigned char* XS = (unsigned char*)(P.ws + WS_XS);
    for (int c = blockIdx.x; c < NTOK / 64; c += gridDim.x) {
        if (wave == 0) { const int t = c * 64 + lane; const int e1 = rte[2 * t], e2 = rte[2 * t + 1]; int p1 = 0, p2 = 0;
            const unsigned long long lt = (1ull << lane) - 1ull;
#pragma unroll
            for (int e = 0; e < 8; ++e) { const unsigned long long m1 = __ballot(e1 == e), m2 = __ballot(e2 == e); const int base = pst[e] + pre[c * 8 + e];
                if (e1 == e) p1 = base + __popcll(m1 & lt);
                if (e2 == e) p2 = base + __popcll(m1) + __popcll(m2 & lt); }
            rtp[2 * t] = p1; rtp[2 * t + 1] = p2; posl[2 * lane] = p1; posl[2 * lane + 1] = p2; }
        __syncthreads();
        for (int idx = wave; idx < 128; idx += 8) { const int t = c * 64 + (idx >> 1); const int d = posl[idx];
            const u32x4* s = (const u32x4*)((const unsigned char*)H3B + (size_t)t * DM) + lane; u32x4* o = (u32x4*)(XS + (size_t)d * DM) + lane;
            o[0] = s[0]; o[64] = s[64]; }
        __syncthreads();
    }
}
__device__ __forceinline__ f32x4 bf4(const u32x2 a) { return (f32x4){__uint_as_float(a.x << 16), __uint_as_float(a.x & 0xffff0000u), __uint_as_float(a.y << 16), __uint_as_float(a.y & 0xffff0000u)}; }
__device__ __forceinline__ f32x4 f84(const unsigned w) { return (f32x4){(float)(w & 0xffu), (float)((w >> 8) & 0xffu), (float)((w >> 16) & 0xffu), (float)(w >> 24)}; }
__device__ __forceinline__ void ln4_load_y(f32x4 (&y)[8], const unsigned char* YM, const unsigned char* YP, int p, int main_rows, int sk, size_t pstride, int lane) {
    if (p < main_rows) { const unsigned* r = (const unsigned*)(YM + (size_t)p * DM) + lane;
#pragma unroll
        for (int j = 0; j < 8; ++j) y[j] = f84(r[64 * j]) - 128.f; }
    else {
#pragma unroll
        for (int j = 0; j < 8; ++j) y[j] = (f32x4){0.f, 0.f, 0.f, 0.f};
        for (int k = 0; k < sk; ++k) { const unsigned* r = (const unsigned*)(YP + (size_t)k * pstride + (size_t)(p - main_rows) * DM) + lane;
#pragma unroll
            for (int j = 0; j < 8; ++j) y[j] = y[j] + (f84(r[64 * j]) - 128.f); } }
}
__device__ __forceinline__ void ln4_load_raw(unsigned (&r)[8], const unsigned char* YM, const unsigned char* YP, int p, int main_rows, int lane) {
    const unsigned* s = (const unsigned*)((p < main_rows) ? YM + (size_t)p * DM : YP + (size_t)(p - main_rows) * DM) + lane;
#pragma unroll
    for (int j = 0; j < 8; ++j) r[j] = __builtin_nontemporal_load(s + 64 * j);
}
__device__ __forceinline__ void ln4_fin_y(f32x4 (&y)[8], const unsigned (&r)[8], const unsigned char* YP, int p, int main_rows, int sk, size_t pstride, int lane) {
#pragma unroll
    for (int j = 0; j < 8; ++j) y[j] = f84(r[j]) - 128.f;
    if (p >= main_rows) for (int k = 1; k < sk; ++k) { const unsigned* s = (const unsigned*)(YP + (size_t)k * pstride + (size_t)(p - main_rows) * DM) + lane;
#pragma unroll
        for (int j = 0; j < 8; ++j) y[j] = y[j] + (f84(s[64 * j]) - 128.f); }
}
__device__ __forceinline__ void ln4_phase(const Params& P, const int tid) {
    const int lane = tid & 63, wave = tid >> 6;
    const bf16_t* Y = (const bf16_t*)(P.ws + WS_Y3B); const float* st3 = (const float*)(P.ws + WS_RT + RT_ST1); const unsigned char* YM = (const unsigned char*)(P.ws + WS_YM); const unsigned char* YP = (const unsigned char*)(P.ws + WS_YM1);
    const float* rtg = (const float*)(P.ws + WS_RT + RT_G); const int* rtp = (const int*)(P.ws + WS_RT + RT_P);
    const int nM = ((const int*)(P.ws + WS_RT + RT_META))[0]; int main_m, sk; pg8::splitk_plan(nM, 8, FFE / 128, gridDim.x, main_m, sk);
    const int main_rows = main_m * 256; const size_t pstride = (size_t)(nM - main_m) * 256 * DM;
#define LN4_LOAD(S, mm) \
        const float S##g1 = rtg[2 * (mm)] * (1.0f / YM_SC), S##g2 = rtg[2 * (mm) + 1] * (1.0f / YM_SC); const int S##p1 = __builtin_amdgcn_readfirstlane(rtp[2 * (mm)]), S##p2 = __builtin_amdgcn_readfirstlane(rtp[2 * (mm) + 1]); \
        const float S##mu = st3[2 * (mm)], S##rs = st3[2 * (mm) + 1]; u32x2 S##yr[8]; unsigned S##ra[8], S##rb[8]; \
        { const u32x2* yr_ = (const u32x2*)(Y + (size_t)(mm) * DM) + lane; _Pragma("unroll") for (int j = 0; j < 8; ++j) S##yr[j] = __builtin_nontemporal_load(yr_ + 64 * j); } \
        ln4_load_raw(S##ra, YM, YP, S##p1, main_rows, lane); ln4_load_raw(S##rb, YM, YP, S##p2, main_rows, lane);
#define LN4_FIN(S, mm, st) { f32x4 v[8], ya[8], yb[8]; ln4_fin_y(ya, S##ra, YP, S##p1, main_rows, sk, pstride, lane); ln4_fin_y(yb, S##rb, YP, S##p2, main_rows, sk, pstride, lane); \
        _Pragma("unroll") for (int j = 0; j < 8; ++j) { const f32x4 h3 = (bf4x(S##yr[j]) - S##mu) * S##rs * *((const f32x4*)P.in[19] + lane + 64 * j) + *((const f32x4*)P.in[20] + lane + 64 * j); \
            v[j] = h3 * DN_ALPHA + ya[j] * S##g1 + yb[j] * S##g2; } \
        ln_norm(v, P.in[25], P.in[26], lane); if (st) ln_store(v, P.out, nullptr, (size_t)(mm), lane); }
    for (int m = blockIdx.x * 8 + wave; m < NTOK; m += gridDim.x * 16) {
        const int mB_ = m + gridDim.x * 8; const bool hasB = mB_ < NTOK; const int mB = hasB ? mB_ : m;
        asm volatile("" ::: "memory");
        LN4_LOAD(a_, m) LN4_LOAD(b_, mB)
        LN4_FIN(a_, m, true)
        asm volatile("" ::: "memory");
        LN4_FIN(b_, mB, hasB)
    }
#undef LN4_LOAD
#undef LN4_FIN
}

__global__ void __launch_bounds__(512, 2) fwd_kernel(Params P) {
    extern __shared__ __attribute__((aligned(16))) unsigned char lds_raw[];
    LAS unsigned char* lds = (LAS unsigned char*)lds_raw;
    volatile LAS unsigned* MISC = (volatile LAS unsigned*)(lds + LDS_MISC);
    int wave_s = __builtin_amdgcn_readfirstlane((int)threadIdx.x >> 6); asm volatile("" : "+s"(wave_s));
#define TID() ({ int l_; asm volatile("v_mbcnt_lo_u32_b32 %0, -1, 0\n\tv_mbcnt_hi_u32_b32 %0, -1, %0" : "=v"(l_)); wave_s * 64 + l_; })
    { const int t0 = TID(); if (t0 < 16) MISC[t0] = 0u; }
    __syncthreads();
    unsigned char* ws = P.ws;
    XcdBarrier bar = xcd_barrier_post((unsigned*)(ws + WS_CTL) + P.li * XCD_BAR_WORDS, MISC + 8, TID());
    const int lo = P.ph_lo, hi = P.ph_hi, G = gridDim.x, cid = blockIdx.x;
#define IN(k) (lo <= (k) && (k) < hi)
#define SEAM(k) do { if (IN((k) + 1)) xcd_barrier(bar, TID()); } while (0)
    bf16_t* QKV0 = (bf16_t*)(ws + WS_QKV0);

    const float* ST1 = (const float*)(ws + WS_RT + RT_ST1); const float* ST2 = (const float*)(ws + WS_RT + RT_ST2);

    constexpr int CVT_LATE = 2560;
    if (IN(0)) { p0_convert(P, lds, TID(), cid, G, CVT_ITEMS - CVT_LATE); __syncthreads(); p0_xprep(P, lds, TID()); SEAM(0); }

    if (IN(1)) {
        p1_cumsum(P, lds, TID()); __syncthreads();
        pg8::Gemm g{(const bf16_t*)(ws + WS_XB), (const bf16_t*)(ws + WS_W_IN0), DM / 2, 0, 1.0f / (ASC_XI8 * WSC_I8IN)}; pg8::TileOrder S; S.init(NTOK / 256, 18, G, cid, nullptr, DM / 128);
        pg8::EpiQKV0 E{QKV0, (const float*)(ws + WS_C128), (const float*)(ws + WS_S128), (float*)(ws + WS_NRM)};
        pg8::gemm_phase<pg8::EpiQKV0, pg8::TileOrder, 2>(lds, g, S, E, TID());
        { const int nfull = (NTOK / 256 * 18) % G;
          if (nfull > 0 && cid >= nfull) { __syncthreads(); colsums_q(P, TID(), cid - nfull, G - nfull); p0_convert(P, lds, TID(), CVT_ITEMS - CVT_LATE + (cid - nfull), G - nfull, CVT_ITEMS); }
          else if (nfull == 0) { __syncthreads(); colsums_q(P, TID(), cid, G); p0_convert(P, lds, TID(), CVT_ITEMS - CVT_LATE + cid, G, CVT_ITEMS); } }
        SEAM(1);
    }
    if (IN(2)) {
        const size_t HS = (size_t)NTOK * 128;
        { att::AttnArgs a{QKV0, QKV0 + 8 * HS, QKV0 + 16 * HS, nullptr, (bf16_t*)(ws + WS_O0), (const float*)(ws + WS_CUMF), nullptr, 8, 8, 1 << 30, DM, (const float*)(ws + WS_NRM), ASC_O};
          att::attn_phase<0>((char*)lds_raw, a, G, cid, TID()); }
        __syncthreads();
        { att::AttnArgs a{QKV0 + 24 * HS, QKV0 + 32 * HS, QKV0 + 34 * HS, nullptr, (bf16_t*)(ws + WS_O0 + 1024), nullptr, P.in[4], 8, 2, 128, DM, nullptr, ASC_O};
          att::attn_phase<1>((char*)lds_raw, a, G, cid, TID()); }
        SEAM(2);
    }
    if (IN(3)) {
        pg8::Gemm g{(const bf16_t*)(ws + WS_O0), (const bf16_t*)(ws + WS_W_OUT0), DM / 2, 0}; pg8::TileOrder S; S.init(NTOK / 256, 8, G, cid, nullptr, DM / 128);
        pg8::EpiResLN<0, 3, true> E{(float*)(ws + WS_Y), P.in[0], nullptr, nullptr, nullptr, (float*)(ws + WS_RT + RT_ST1), (void*)(ws + WS_H1B), 1.0f / (ASC_O * WSC_O), ASC_YI8};
        pg8::gemm_phase<pg8::EpiResLN<0, 3, true>, pg8::TileOrder, true>(lds, g, S, E, TID()); SEAM(3);
    }
    if (IN(4)) {
        const float* Cv = (const float*)(ws + WS_RT + RT_CGU); const float* Dv = (const float*)(ws + WS_RT + RT_DGU);
        if constexpr (FP8_GU0) {
            pg8::Gemm g{(const bf16_t*)(ws + WS_H1B), (const bf16_t*)(ws + WS_W_GU0), DM / 2, 0, 1.0f / (ASC_YI8 * WSC_I8GU), ASC_ACT}; pg8::TileOrder S; S.init(NTOK / 256, 44, G, cid, nullptr, DM / 128);
            pg8::EpiSwiGLU<true, true, true> E{(void*)(ws + WS_ACT0), FFD, 1.0f, ASC_ACT, ST1, Cv, Dv};
            pg8::gemm_phase<pg8::EpiSwiGLU<true, true, true>, pg8::TileOrder, 2>(lds, g, S, E, TID());
        } else {
            pg8::Gemm g{(const bf16_t*)(ws + WS_H1B), (const bf16_t*)(ws + WS_W_GU0), DM, 0}; pg8::TileOrder S; S.init(NTOK / 256, 44, G, cid, nullptr, DM / 64);
            pg8::EpiSwiGLU<true, true> E{(void*)(ws + WS_ACT0), FFD, 1.0f, ASC_ACT, ST1, Cv, Dv};
            pg8::gemm_phase(lds, g, S, E, TID());
        }
        SEAM(4);
    }
    if (IN(5)) {
        pg8::Gemm g{(const bf16_t*)(ws + WS_ACT0), (const bf16_t*)(ws + WS_W_D0), FFD / 2, 0}; pg8::TileOrder S; S.init(NTOK / 256, 8, G, cid, nullptr, FFD / 128);
        pg8::EpiResLN<1, 3, true> E{(float*)(ws + WS_Y), (const float*)(ws + WS_Y), ST1, P.in[6], P.in[7], (float*)(ws + WS_RT + RT_ST2), (void*)(ws + WS_H2B), 1.0f / (ASC_ACT * WSC_DOWN), ASC_YI8};
        pg8::gemm_phase<pg8::EpiResLN<1, 3, true>, pg8::TileOrder, true>(lds, g, S, E, TID()); SEAM(5);
    }
    if (IN(6)) {
        pg8::Gemm g{(const bf16_t*)(ws + WS_H2B), (const bf16_t*)(ws + WS_W_IN1), DM / 2, 0, 1.0f / (ASC_YI8 * WSC_I8IN)}; pg8::TileOrder S; S.init(NTOK / 256, 4, G, cid, nullptr, DM / 128);
        pg8::EpiMlaDown E{(bf16_t*)(ws + WS_CQ), (bf16_t*)(ws + WS_CKV), (bf16_t*)(ws + WS_KPE), (float*)(ws + WS_SSQ), (const float*)(ws + WS_C64), (const float*)(ws + WS_S64), ST2,
                          (const float*)(ws + WS_RT + RT_CIN), (const float*)(ws + WS_RT + RT_DIN), ASC_LI8};
        pg8::gemm_phase<pg8::EpiMlaDown, pg8::TileOrder, 2>(lds, g, S, E, TID()); SEAM(6);
    }
    if (IN(7)) {
        const int G4 = G / 4;
        if (cid < G4) { pg8::Gemm g{(const bf16_t*)(ws + WS_H2B), (const bf16_t*)(ws + WS_W_IN1 + (size_t)1024 * DM), DM / 2, 0, 1.0f / (ASC_YI8 * WSC_I8IN)}; pg8::TileOrder S; S.init(NTOK / 256, 1, G4, cid, nullptr, DM / 128);
          pg8::EpiKpe E{(bf16_t*)(ws + WS_KPE), (const float*)(ws + WS_C64), (const float*)(ws + WS_S64), ST2, (const float*)(ws + WS_RT + RT_CIN), (const float*)(ws + WS_RT + RT_DIN)};
          pg8::gemm_phase<pg8::EpiKpe, pg8::TileOrder, 2>(lds, g, S, E, TID()); }
        else { pg8::Gemm g{(const bf16_t*)(ws + WS_CQ), (const bf16_t*)(ws + WS_W_UQ), 256, 0, 1.0f / (ASC_LI8 * WSC_I8UP)}; pg8::TileOrder S; S.init(NTOK / 256, 12, G - G4, cid - G4, nullptr, 512 / 128);
          pg8::EpiMlaQ E{(bf16_t*)(ws + WS_Q1), (const float*)(ws + WS_SSQ), (const float*)(ws + WS_C64), (const float*)(ws + WS_S64)};
          pg8::gemm_phase<pg8::EpiMlaQ, pg8::TileOrder, 2>(lds, g, S, E, TID()); }
        __syncthreads();
        { pg8::Gemm g{(const bf16_t*)(ws + WS_CKV), (const bf16_t*)(ws + WS_W_UKV), 256, 0, 1.0f / (ASC_LI8 * WSC_I8UP)}; pg8::TileOrder S; S.init(NTOK / 256, 8, G, cid, nullptr, 512 / 128);
          pg8::EpiMlaKV E{(bf16_t*)(ws + WS_KN1), (bf16_t*)(ws + WS_V1), (const float*)(ws + WS_SSQ)};
          pg8::gemm_phase<pg8::EpiMlaKV, pg8::TileOrder, 2>(lds, g, S, E, TID()); }
        __syncthreads();
        { pg8::Gemm g{(const bf16_t*)(ws + WS_CKV), (const bf16_t*)(ws + WS_W_UKV + (size_t)2048 * 512), 256, 0, 0.5f / (ASC_LI8 * WSC_I8UP)}; pg8::TileOrder S; S.init(NTOK / 256, 8, G, cid, nullptr, 512 / 128);
          pg8::EpiMlaVT E{(unsigned char*)(ws + WS_V1), (const float*)(ws + WS_SSQ), 8.0f};
          pg8::gemm_phase<pg8::EpiMlaVT, pg8::TileOrder, 2, true>(lds, g, S, E, TID()); }
        SEAM(7);
    }
    if (IN(8)) {
        att::AttnArgs a{(const bf16_t*)(ws + WS_Q1), (const bf16_t*)(ws + WS_KN1), (const bf16_t*)(ws + WS_V1), (const bf16_t*)(ws + WS_KPE), (bf16_t*)(ws + WS_O1), nullptr, nullptr, 16, 16, 1 << 30, DM, nullptr, ASC_O};
        att::attn_phase<2>((char*)lds_raw, a, G, cid, TID()); SEAM(8);
    }
    if (IN(9)) {
        pg8::Gemm g{(const bf16_t*)(ws + WS_O1), (const bf16_t*)(ws + WS_W_OUT1), DM / 2, 0}; pg8::TileOrder S; S.init(NTOK / 256, 8, G, cid, nullptr, DM / 128);
        pg8::EpiResLN<1, 4, false> E{(float*)(ws + WS_Y), (const float*)(ws + WS_Y), ST2, P.in[11], P.in[12], nullptr, (void*)(ws + WS_Y3B), 1.0f / (ASC_O * WSC_O), 0.f};
        pg8::gemm_phase<pg8::EpiResLN<1, 4, false>, pg8::TileOrder, true>(lds, g, S, E, TID()); SEAM(9);
    }
    if (IN(10)) { ln3_router_phase(P, lds, TID()); SEAM(10); }
    if (IN(11)) { perm_phase(P, lds, TID()); SEAM(11); }
    const int* meta = (const int*)(ws + WS_RT + RT_META);
    if (IN(12)) {
        pg8::Gemm g{(const bf16_t*)(ws + WS_XS), (const bf16_t*)(ws + WS_W_MGU), DM / 2, (size_t)14336 * 2048, 1.0f / (ASC_XI8 * WSC_I8GU), ASC_ACT}; pg8::TileOrder S; S.init(meta[0], 56, G, cid, meta + 1, DM / 128);
        pg8::EpiSwiGLU<true, false, true> E{(void*)(ws + WS_ACT1), FFE, 1.0f, ASC_ACT, nullptr, nullptr, nullptr};
        pg8::gemm_phase<pg8::EpiSwiGLU<true, false, true>, pg8::TileOrder, 2>(lds, g, S, E, TID()); SEAM(12);
    }
    if (IN(13)) {
        int main_m, sk; pg8::splitk_plan(meta[0], 8, FFE / 128, G, main_m, sk);
        pg8::Gemm g{(const bf16_t*)(ws + WS_ACT1), (const bf16_t*)(ws + WS_W_MD), FFE / 2, (size_t)2048 * FFE};
        { pg8::TileOrder S; S.init(main_m, 8, G, cid, meta + 1, FFE / 128);
          pg8::EpiBf16 E{(bf16_t*)(ws + WS_YM), DM, 0, 0, 1.0f / (ASC_ACT * WSC_DOWN), -YM_SC};
          pg8::gemm_phase<pg8::EpiBf16, pg8::TileOrder, true>(lds, g, S, E, TID()); }
        __syncthreads();
        pg8::SplitKOrder S; S.init(meta[0], 8, FFE / 128, G, cid, meta + 1);
        pg8::EpiBf16 E{(bf16_t*)(ws + WS_YM1), DM, main_m * 256, (size_t)(meta[0] - main_m) * 256 * DM, 1.0f / (ASC_ACT * WSC_DOWN), -YM_SC};
        pg8::gemm_phase<pg8::EpiBf16, pg8::SplitKOrder, true>(lds, g, S, E, TID()); SEAM(13);
    }
    if (IN(14)) { ln4_phase(P, TID()); }
#undef IN
#undef SEAM
#undef TID
}

extern "C" void kernel_launch(void* const* d_in, const int* in_sizes, int n_in, void* d_out, int out_size, void* d_ws, size_t ws_size, hipStream_t stream) {
    static int grid = 0;
    if (grid == 0) {
        if (n_in != 27 || out_size != NTOK * DM || ws_size < WS_END) { fprintf(stderr, "kernel_launch: unexpected shapes (n_in %d out %d ws %zu need %zu)\n", n_in, out_size, ws_size, (size_t)WS_END); grid = -1; return; }
        int dev = 0, cus = 0;
        if (hipGetDevice(&dev) != hipSuccess || hipDeviceGetAttribute(&cus, hipDeviceAttributeMultiprocessorCount, dev) != hipSuccess) { grid = -1; return; }
        if (hipFuncSetAttribute((const void*)fwd_kernel, hipFuncAttributeMaxDynamicSharedMemorySize, LDS_BYTES) != hipSuccess) { fprintf(stderr, "kernel_launch: hipFuncSetAttribute failed\n"); grid = -1; return; }
        int per_cu = 0;
        if (hipOccupancyMaxActiveBlocksPerMultiprocessor(&per_cu, (const void*)fwd_kernel, 512, LDS_BYTES) != hipSuccess || per_cu < 1) fprintf(stderr, "kernel_launch: occupancy query reports %d\n", per_cu);
        (void)hipGetLastError();
        grid = cus;
    }
    if (grid < 0) return;
    (void)hipMemsetAsync((char*)d_ws + WS_CTL, 0, CTL_ZERO_BYTES, stream);
    Params p{};
    for (int i = 0; i < 27; ++i) p.in[i] = (const float*)d_in[i];
    p.out = (float*)d_out; p.ws = (unsigned char*)d_ws;
    for (int i = 0; i < 64; ++i) p.invf128[i] = std::pow(10000.0, -2.0 * i / 128.0);
    for (int i = 0; i < 32; ++i) p.invf64[i] = std::pow(10000.0, -2.0 * i / 64.0);
#if defined(PROBE_REP_LO)
    p.ph_lo = 0; p.ph_hi = PROBE_REP_HI; p.li = 0; hipLaunchKernelGGL(fwd_kernel, dim3(grid), dim3(512), LDS_BYTES, stream, p);
    p.ph_lo = PROBE_REP_LO; p.ph_hi = PROBE_REP_HI; p.li = 1; hipLaunchKernelGGL(fwd_kernel, dim3(grid), dim3(512), LDS_BYTES, stream, p);
    if (PROBE_REP_HI < NPHASE) { p.ph_lo = PROBE_REP_HI; p.ph_hi = NPHASE; p.li = 2; hipLaunchKernelGGL(fwd_kernel, dim3(grid), dim3(512), LDS_BYTES, stream, p); }
#else
    p.ph_lo = 0; p.ph_hi = NPHASE; p.li = 0; hipLaunchKernelGGL(fwd_kernel, dim3(grid), dim3(512), LDS_BYTES, stream, p);
#endif
}
```

```cpp
#include <hip/hip_runtime.h>
#include <cstdio>
#include <cstdint>
#include <cmath>

#define LAS __attribute__((address_space(3)))
typedef unsigned short bf16_t;
typedef short bf16x8 __attribute__((ext_vector_type(8)));
typedef short s16x4 __attribute__((ext_vector_type(4)));
typedef float f32x4 __attribute__((ext_vector_type(4)));
typedef float f32x2 __attribute__((ext_vector_type(2)));
typedef float f32x16 __attribute__((ext_vector_type(16)));
typedef unsigned u32x4 __attribute__((ext_vector_type(4)));
typedef unsigned u32x2 __attribute__((ext_vector_type(2)));

constexpr int NTOK = 16384, DM = 2048, SEQ = 4096, NBATCH = 4;
constexpr int FFD = 5632, FFE = 7168, NEXP = 8;
constexpr int MOE_TILES_MAX = 136;
constexpr float LN_EPS = 1e-5f, RMS_EPS = 1e-6f;
constexpr float DN_ALPHA = 1.4142135623730951f;

__device__ __forceinline__ unsigned cvt_pk_bf16(float lo, float hi) { unsigned r; asm volatile("v_cvt_pk_bf16_f32 %0, %1, %2" : "=v"(r) : "v"(lo), "v"(hi)); return r; }

#define XB_TMO      128
#define XB_XCNT(j)  (256  + 64 * (j))
#define XB_XSUB(j)  (1280 + 64 * (j))
#define XB_XGEN(j)  (2304 + 64 * (j))
#define XB_TOP      3328
#define XB_TOPGEN   3392
#define XCD_BAR_WORDS 3456
#define XB_SPIN_CAP (1u << 20)
__device__ __forceinline__ unsigned xb_ld(unsigned* p)              { return __hip_atomic_load(p, __ATOMIC_RELAXED, __HIP_MEMORY_SCOPE_AGENT); }
__device__ __forceinline__ unsigned xb_add(unsigned* p, unsigned v) { return __hip_atomic_fetch_add(p, v, __ATOMIC_RELAXED, __HIP_MEMORY_SCOPE_AGENT); }
__device__ __forceinline__ unsigned xb_xcc_id() { return (unsigned)__builtin_amdgcn_s_getreg((3 << 11) | 20) & 0xFu; }
#define XB_SPIN(cond, bar) do { unsigned _sp = 0; while (cond) { __builtin_amdgcn_s_sleep(1); \
    if ((++_sp & 255u) == 0u) { if (xb_ld(&(bar)[XB_TMO])) break; if (_sp > XB_SPIN_CAP) { atomicAdd(&(bar)[XB_TMO], 1u); break; } } } } while (0)
struct XcdBarrier { unsigned* bar; unsigned x; volatile LAS unsigned* st; };
__device__ __forceinline__ XcdBarrier xcd_barrier_post(unsigned* bar, volatile LAS unsigned* st, const int tid) {
    XcdBarrier b; b.bar = bar; b.x = xb_xcc_id(); b.st = st;
    if (tid == 0) (void)xb_add(&bar[XB_XCNT(b.x)], 1u);
    return b;
}
__device__ __forceinline__ void xcd_barrier_complete(unsigned* bar, unsigned x, unsigned& nloc, unsigned& nx) {
    const unsigned G = gridDim.x * gridDim.y * gridDim.z;
    unsigned sum, cnt, mine, sp = 0u;
    for (;;) {
        sum = 0u; cnt = 0u; mine = 0u;
#pragma unroll
        for (unsigned j = 0; j < 16; ++j) { const unsigned c = xb_ld(&bar[XB_XCNT(j)]); sum += c; cnt += (c > 0u) ? 1u : 0u; mine = (j == x) ? c : mine; }
        if (sum == G) break;
        __builtin_amdgcn_s_sleep(1);
        if ((++sp & 255u) == 0u) { if (xb_ld(&bar[XB_TMO])) break; if (sp > XB_SPIN_CAP) { atomicAdd(&bar[XB_TMO], 1u); break; } }
    }
    nloc = mine > 0u ? mine : 1u; nx = cnt > 0u ? cnt : 1u;
}
__device__ __forceinline__ void xcd_barrier(const XcdBarrier& b, const int tid) {
    asm volatile("s_waitcnt vmcnt(0)" ::: "memory");
    __syncthreads();
    if (tid == 0) {
        unsigned* bar = b.bar;
        __builtin_amdgcn_s_waitcnt(0);
        unsigned nloc = b.st[0], nx = b.st[1];
        if (nloc == 0u) { xcd_barrier_complete(bar, b.x, nloc, nx); b.st[0] = nloc; b.st[1] = nx; }
        const unsigned old = xb_add(&bar[XB_XSUB(b.x)], 1u);
        const unsigned gen = old / nloc;
        if (old + 1u == (gen + 1u) * nloc) {
            __builtin_amdgcn_fence(__ATOMIC_RELEASE, "agent");
            asm volatile("s_waitcnt vmcnt(0)" ::: "memory");
            const unsigned og = xb_add(&bar[XB_TOP], 1u);
            const unsigned tg = og / nx;
            if (og + 1u == (tg + 1u) * nx) xb_add(&bar[XB_TOPGEN], 1u);
            else XB_SPIN(xb_ld(&bar[XB_TOPGEN]) == tg, bar);
            __builtin_amdgcn_fence(__ATOMIC_ACQUIRE, "agent");
            xb_add(&bar[XB_XGEN(b.x)], 1u);
            asm volatile("s_waitcnt vmcnt(0)" ::: "memory");
        } else {
            XB_SPIN(xb_ld(&bar[XB_XGEN(b.x)]) == gen, bar);
            __builtin_amdgcn_fence(__ATOMIC_ACQUIRE, "agent");
            asm volatile("s_waitcnt vmcnt(0)" ::: "memory");
        }
    }
    __syncthreads();
}

namespace pg8 {
constexpr int BM = 256, BK = 64, HALF = 128, HTB = HALF * BK * 2, STAGE_BYTES = 8 * HTB, NXCD = 8, WGM = 8;
__host__ __device__ __forceinline__ int lds_byte(int r, int c) { const int st = (r >> 4) * 2 + (c >> 5), rr = r & 15, cc = c & 31, ob = rr * 64 + cc * 2; return st * 1024 + (ob ^ (((ob >> 9) & 1) << 5)); }
__host__ __device__ __forceinline__ void stage_rc(int b, int& R, int& C) { const int st = b / 1024, sb = b % 1024, swz = sb ^ (((sb >> 9) & 1) << 5); R = (st >> 1) * 16 + swz / 64; C = (st & 1) * 32 + (swz % 64) / 2; }
__host__ __device__ __forceinline__ int perm32(int rho) { const int n = rho >> 4, i = rho & 15; return 8 * (i >> 2) + 4 * n + (i & 3); }

struct Unit { int pm, pn, e, kt0, nkt, buf; };
struct Gemm { const bf16_t* A; const bf16_t* Bt; int K; size_t estride; float qs = 1.0f, qs_b1 = 1.0f; };

struct TileOrder {
    int nM, nN, nwg, G, c, nt; const int* ts;
    __device__ __forceinline__ void init(int nM_, int nN_, int G_, int c_, const int* ts_, int nt_) { nM = nM_; nN = nN_; nwg = nM * nN; G = G_; c = c_; ts = ts_; nt = nt_; }
    __device__ __forceinline__ bool next(int i, Unit& u) const {
        const long L = (long)i * G + c; if (L >= nwg) return false;
        int wgid = (int)L; { const int q = nwg / NXCD, r = nwg % NXCD, xcd = wgid % NXCD, off = wgid / NXCD; wgid = (xcd < r ? xcd * (q + 1) : r * (q + 1) + (xcd - r) * q) + off; }
        const int nig = WGM * nN, gid = wgid / nig, fm = gid * WGM, gsz = (nM - fm) < WGM ? (nM - fm) : WGM;
        u.pm = fm + ((wgid % nig) % gsz); u.pn = (wgid % nig) / gsz; u.e = 0; u.kt0 = 0; u.nkt = nt; u.buf = 0;
        if (ts) { int e = 0;
#pragma unroll
            for (int j = 1; j < 8; ++j) e += (u.pm >= ts[j]) ? 1 : 0;
            u.e = e; }
        return true;
    }
};

__device__ __forceinline__ void splitk_plan(int nM, int nN, int nt, int G, int& main_m, int& s) {
    main_m = ((nM * nN) / G) * G / nN; const int R = (nM - main_m) * nN; s = 1;
    if (R > 0) { const int cap = G / R; const int cand[8] = {1, 2, 4, 7, 8, 14, 28, 56};
#pragma unroll
        for (int i = 0; i < 8; ++i) if (cand[i] <= cap && nt % (2 * cand[i]) == 0) s = cand[i]; }
}
struct SplitKOrder {
    int nN, R, s, main_m, nkt, v; const int* ts;
    __device__ __forceinline__ void init(int nM, int nN_, int nt, int G, int v_, const int* ts_) { nN = nN_; ts = ts_; v = v_; splitk_plan(nM, nN, nt, G, main_m, s); R = (nM - main_m) * nN; nkt = nt / s; }
    __device__ __forceinline__ bool next(int i, Unit& u) const {
        if (i > 0 || v >= R * s) return false;
        const int ks = v % s, r = v / s;
        u.pm = main_m + r / nN; u.pn = r % nN; u.kt0 = ks * nkt; u.nkt = nkt; u.buf = ks; u.e = 0;
        if (ts) { int e = 0;
#pragma unroll
            for (int j = 1; j < 8; ++j) e += (u.pm >= ts[j]) ? 1 : 0;
            u.e = e; }
        return true;
    }
};

typedef int v8i __attribute__((ext_vector_type(8)));
typedef int v4i __attribute__((ext_vector_type(4)));
__device__ __forceinline__ v8i cat8(const bf16x8 a, const bf16x8 b) { const u32x4 x = __builtin_bit_cast(u32x4, a), y = __builtin_bit_cast(u32x4, b); return (v8i){(int)x[0], (int)x[1], (int)x[2], (int)x[3], (int)y[0], (int)y[1], (int)y[2], (int)y[3]}; }
template <class Epi, class Sched, int QM = 0, bool SWAP = false>
__device__ __forceinline__ void gemm_phase(LAS unsigned char* lds, const Gemm g, const Sched& S, const Epi& E, const int tid) {
    const int wid = __builtin_amdgcn_readfirstlane(tid >> 6), lane = tid & 63, wr = wid >> 2, wc = wid & 3, fr = lane & 15, fq = lane >> 4;
    const int K = g.K;
    unsigned voffA[2], voffB[2];
#pragma unroll
    for (int i = 0; i < 2; ++i) { int R, C; stage_rc(tid * 16 + i * 8192, R, C); const int Rb = Epi::PERM ? ((R & ~31) + perm32(R & 31)) : R;
        voffA[i] = (unsigned)(R * K + C) * 2u; voffB[i] = (unsigned)(Rb * K + C) * 2u; }
    const size_t kstep = (size_t)(BK * 2);
    const size_t hstep = (size_t)HALF * K * 2;
    const size_t tstep = 2 * hstep;
    const unsigned ldsw = (unsigned)wid * 1024u;
    const int aoff = lds_byte(wr * 64 + fr, fq * 8), boff = lds_byte(wc * 32 + fr, fq * 8);
#define PG8_SA(b, h) (((b) * 2 + (h)) * HTB)
#define PG8_SB(b, h) ((4 + (b) * 2 + (h)) * HTB)
#define PG8_STAGE(bufoff, gbase, voff) do { _Pragma("unroll") for (int _i = 0; _i < 2; ++_i) \
        __builtin_amdgcn_global_load_lds((const unsigned*)((const char*)(gbase) + (voff)[_i]), (LAS unsigned*)(lds + (bufoff) + ldsw + _i * 8192), 16, 0, 0); } while (0)
#define PG8_LDA(dst, b, h) do { _Pragma("unroll") for (int m = 0; m < 4; ++m) _Pragma("unroll") for (int k = 0; k < 2; ++k) dst[m][k] = *(const LAS bf16x8*)(lds + PG8_SA(b, h) + aoff + m * 2048 + k * 1024); } while (0)
#define PG8_LDB(dst, b, h) do { _Pragma("unroll") for (int n = 0; n < 2; ++n) _Pragma("unroll") for (int k = 0; k < 2; ++k) dst[n][k] = *(const LAS bf16x8*)(lds + PG8_SB(b, h) + boff + n * 2048 + k * 1024); } while (0)
#define PG8_MMA(ai, bj, At, Bt) do { __builtin_amdgcn_s_setprio(1); _Pragma("unroll") for (int m = 0; m < 4; ++m) _Pragma("unroll") for (int n = 0; n < 2; ++n) { \
        if constexpr (QM == 1) { const v8i b8_ = cat8(Bt[n][0], Bt[n][1]), a8_ = cat8(At[m][0], At[m][1]); asm volatile("v_mfma_scale_f32_16x16x128_f8f6f4 %0, %1, %2, %0, %3, %3 op_sel_hi:[0,0,0]" : "+v"(acc[ai][bj][m][n]) : "v"(b8_), "v"(a8_), "v"(sc1_)); } \
        else if constexpr (QM == 2) { _Pragma("unroll") for (int k = 0; k < 2; ++k) acc[ai][bj][m][n] = __builtin_bit_cast(f32x4, SWAP ? __builtin_amdgcn_mfma_i32_16x16x64_i8(__builtin_bit_cast(v4i, At[m][k]), __builtin_bit_cast(v4i, Bt[n][k]), __builtin_bit_cast(v4i, acc[ai][bj][m][n]), 0, 0, 0) \
                                                                                                : __builtin_amdgcn_mfma_i32_16x16x64_i8(__builtin_bit_cast(v4i, Bt[n][k]), __builtin_bit_cast(v4i, At[m][k]), __builtin_bit_cast(v4i, acc[ai][bj][m][n]), 0, 0, 0)); } \
        else { _Pragma("unroll") for (int k = 0; k < 2; ++k) acc[ai][bj][m][n] = __builtin_amdgcn_mfma_f32_16x16x32_bf16(Bt[n][k], At[m][k], acc[ai][bj][m][n], 0, 0, 0); } } __builtin_amdgcn_s_setprio(0); } while (0)
#define PG8_WAIT_V(n) asm volatile("s_waitcnt vmcnt(" #n ")" ::: "memory")
#define PG8_WAIT_L(n) asm volatile("s_waitcnt lgkmcnt(" #n ")" ::: "memory")
#define PG8_BAR __builtin_amdgcn_s_barrier()
#define PG8_SCHED __builtin_amdgcn_sched_barrier(0)
    Unit cur, nxt; int ui = 0;
    if (!S.next(0, cur)) return;
    const int sc1_ = 0x7F7F7F7F; (void)sc1_;
    f32x4 acc[2][2][4][2];
#pragma unroll
    for (int a = 0; a < 2; ++a)
#pragma unroll
        for (int b = 0; b < 2; ++b)
#pragma unroll
            for (int m = 0; m < 4; ++m)
#pragma unroll
                for (int n = 0; n < 2; ++n) acc[a][b][m][n] = (f32x4){0.f, 0.f, 0.f, 0.f};
    bf16x8 At[4][2], B0[2][2], B1[2][2];
    const char* cA = (const char*)g.A + (size_t)cur.pm * tstep + (size_t)cur.kt0 * kstep; const char* cB = (const char*)g.Bt + (size_t)cur.e * g.estride + (size_t)cur.pn * tstep + (size_t)cur.kt0 * kstep;
    PG8_STAGE(PG8_SB(0, 0), cB, voffB); PG8_STAGE(PG8_SB(0, 1), cB + hstep, voffB); PG8_STAGE(PG8_SA(0, 0), cA, voffA); PG8_STAGE(PG8_SA(0, 1), cA + hstep, voffA);
    if (wr == 1) PG8_BAR;
    PG8_WAIT_V(2); PG8_BAR;
    PG8_STAGE(PG8_SB(1, 0), cB + kstep, voffB); PG8_STAGE(PG8_SA(1, 0), cA + kstep, voffA); PG8_STAGE(PG8_SB(1, 1), cB + hstep + kstep, voffB);
    PG8_WAIT_V(6); PG8_BAR;
    for (;;) {
        const bool has_next = S.next(ui + 1, nxt);
        const char* nA = has_next ? (const char*)g.A + (size_t)nxt.pm * tstep + (size_t)nxt.kt0 * kstep : cA; const char* nB = has_next ? (const char*)g.Bt + (size_t)nxt.e * g.estride + (size_t)nxt.pn * tstep + (size_t)nxt.kt0 * kstep : cB;
        const int nt = cur.nkt;
        for (int t = 0; t < nt; t += 2) {
            const bool last = (t == nt - 2);
            const char* a1 = cA + (size_t)(t + 1) * kstep;
            const char* a2 = last ? nA : cA + (size_t)(t + 2) * kstep; const char* b2 = last ? nB : cB + (size_t)(t + 2) * kstep;
            const char* a3 = a2 + kstep; const char* b3 = b2 + kstep;
            PG8_LDB(B0, 0, 0); PG8_LDB(B1, 0, 1); PG8_SCHED; PG8_LDA(At, 0, 0); PG8_STAGE(PG8_SA(1, 1), a1 + hstep, voffA);
            PG8_WAIT_V(8); PG8_WAIT_L(0); PG8_BAR; PG8_MMA(0, 0, At, B0); PG8_MMA(0, 1, At, B1); PG8_BAR; PG8_SCHED;
            PG8_LDA(At, 0, 1); PG8_STAGE(PG8_SB(0, 0), b2, voffB); PG8_STAGE(PG8_SB(0, 1), b2 + hstep, voffB); PG8_STAGE(PG8_SA(0, 0), a2, voffA);
            PG8_WAIT_V(8); PG8_WAIT_L(0); PG8_BAR; PG8_MMA(1, 0, At, B0); PG8_MMA(1, 1, At, B1); PG8_BAR; PG8_SCHED;
            PG8_LDB(B0, 1, 0); PG8_LDB(B1, 1, 1); PG8_SCHED; PG8_LDA(At, 1, 0); PG8_STAGE(PG8_SA(0, 1), a2 + hstep, voffA);
            PG8_WAIT_V(8); PG8_WAIT_L(0); PG8_BAR; PG8_MMA(0, 0, At, B0); PG8_MMA(0, 1, At, B1); PG8_BAR; PG8_SCHED;
            PG8_LDA(At, 1, 1); PG8_STAGE(PG8_SB(1, 0), b3, voffB); PG8_STAGE(PG8_SB(1, 1), b3 + hstep, voffB); PG8_STAGE(PG8_SA(1, 0), a3, voffA);
            PG8_WAIT_V(8); PG8_WAIT_L(0); PG8_BAR; PG8_MMA(1, 0, At, B0); PG8_MMA(1, 1, At, B1); PG8_BAR; PG8_SCHED;
        }
        if constexpr (QM == 2) { const float qs0_ = g.qs * E.qscale(cur), qs1_ = qs0_ * g.qs_b1; _Pragma("unroll") for (int a = 0; a < 2; ++a) _Pragma("unroll") for (int b = 0; b < 2; ++b) _Pragma("unroll") for (int m = 0; m < 4; ++m) _Pragma("unroll") for (int n = 0; n < 2; ++n) { const v4i t_ = __builtin_bit_cast(v4i, acc[a][b][m][n]); acc[a][b][m][n] = (f32x4){(float)t_[0], (float)t_[1], (float)t_[2], (float)t_[3]} * (b == 0 ? qs0_ : qs1_); } }
        if constexpr (QM == 1) asm volatile("s_nop 15\n\ts_nop 15\n\ts_nop 15" ::: "memory");
        if (wr == 0) PG8_BAR;
        E(acc, cur, wr, wc, fr, fq);
        if (!has_next) break;
#pragma unroll
        for (int a = 0; a < 2; ++a)
#pragma unroll
            for (int b = 0; b < 2; ++b)
#pragma unroll
                for (int m = 0; m < 4; ++m)
#pragma unroll
                    for (int n = 0; n < 2; ++n) acc[a][b][m][n] = (f32x4){0.f, 0.f, 0.f, 0.f};
        cur = nxt; cA = nA; cB = nB; ++ui;
        if (wr == 1) PG8_BAR;
    }
    PG8_WAIT_V(0);
    PG8_BAR;
#undef PG8_SA
#undef PG8_SB
#undef PG8_STAGE
#undef PG8_LDA
#undef PG8_LDB
#undef PG8_MMA
#undef PG8_WAIT_V
#undef PG8_WAIT_L
#undef PG8_BAR
#undef PG8_SCHED
}

#define EPI_ARGS const f32x4 (&acc)[2][2][4][2], const Unit& u, int wr, int wc, int fr, int fq
__device__ __forceinline__ float clamp448(float x) { return __builtin_amdgcn_fmed3f(x, -448.0f, 448.0f); }
__device__ __forceinline__ u32x2 pack8fp8(const f32x4 a, const f32x4 b) {
    int lo = __builtin_amdgcn_cvt_pk_fp8_f32(clamp448(a[0]), clamp448(a[1]), 0, false); lo = __builtin_amdgcn_cvt_pk_fp8_f32(clamp448(a[2]), clamp448(a[3]), lo, true);
    int hi = __builtin_amdgcn_cvt_pk_fp8_f32(clamp448(b[0]), clamp448(b[1]), 0, false); hi = __builtin_amdgcn_cvt_pk_fp8_f32(clamp448(b[2]), clamp448(b[3]), hi, true);
    return (u32x2){(unsigned)lo, (unsigned)hi}; }
__device__ __forceinline__ unsigned pack4i8(const f32x4 t) {
    const float M = 12582912.f; const unsigned a = __float_as_uint(__builtin_amdgcn_fmed3f(t[0], -127.f, 127.f) + M), b = __float_as_uint(__builtin_amdgcn_fmed3f(t[1], -127.f, 127.f) + M),
                   c = __float_as_uint(__builtin_amdgcn_fmed3f(t[2], -127.f, 127.f) + M), d = __float_as_uint(__builtin_amdgcn_fmed3f(t[3], -127.f, 127.f) + M);
    return __builtin_amdgcn_perm(b, a, 0x0c0c0400u) | __builtin_amdgcn_perm(d, c, 0x04000c0cu); }
__device__ __forceinline__ u32x2 pack8i8(const f32x4 a, const f32x4 b) { return (u32x2){pack4i8(a), pack4i8(b)}; }
__device__ __forceinline__ u32x4 pack8bf(const f32x4 a, const f32x4 b) { u32x4 w; w.x = cvt_pk_bf16(a[0], a[1]); w.y = cvt_pk_bf16(a[2], a[3]); w.z = cvt_pk_bf16(b[0], b[1]); w.w = cvt_pk_bf16(b[2], b[3]); return w; }

struct EpiQKV0 {
    static constexpr bool PERM = true;
    __device__ __forceinline__ float qscale(const Unit& u) const { return ((u.pn >= 8 && u.pn <= 11) || u.pn == 17) ? 0.5f : 1.0f; }
    bf16_t* O; const float* cs; const float* sn; float* nrm;
    __device__ __forceinline__ void operator()(EPI_ARGS) const {
        const int row0 = u.pm * BM + wr * 64 + fr; const bool rot = (u.pn >= 12 && u.pn <= 16); const int fi = 16 * wc + 4 * fq;
#pragma unroll
        for (int ai = 0; ai < 2; ++ai)
#pragma unroll
            for (int m = 0; m < 4; ++m) { const int row = row0 + ai * HALF + m * 16;
                f32x4 c4 = (f32x4){1.f, 1.f, 1.f, 1.f}, s4 = (f32x4){0.f, 0.f, 0.f, 0.f};
                if (rot) { c4 = *(const f32x4*)(cs + (size_t)row * 64 + fi); s4 = *(const f32x4*)(sn + (size_t)row * 64 + fi); }
#pragma unroll
                for (int bj = 0; bj < 2; ++bj) { const int hd = 2 * u.pn + bj; const f32x4 v0 = acc[ai][bj][m][0], v1 = acc[ai][bj][m][1];
                    const f32x4 o0 = v0 * c4 - v1 * s4, o1 = v1 * c4 + v0 * s4;
                    *(u32x4*)(O + ((size_t)hd * NTOK + row) * 128 + 32 * wc + 8 * fq) = pack8bf(o0, o1);
                    if (u.pn < 8) { float s = ((o0[0] * o0[0] + o0[1] * o0[1]) + (o0[2] * o0[2] + o0[3] * o0[3])) + ((o1[0] * o1[0] + o1[1] * o1[1]) + (o1[2] * o1[2] + o1[3] * o1[3]));
                        s += __shfl_xor(s, 16); s += __shfl_xor(s, 32);
                        if (fq == 0) nrm[((size_t)hd * NTOK + row) * 4 + wc] = s; } } }
    }
};
__device__ __forceinline__ void ln_stats(const float* st, int row, float& mu, float& rs) { const f32x2 s = *(const f32x2*)(st + 2 * (size_t)row); mu = s[0] * (1.0f / DM); rs = 1.0f / sqrtf(s[1] * (1.0f / DM) - mu * mu + LN_EPS); }
template <int RESLN, int COPY, bool STATS> struct EpiResLN {
    static constexpr bool PERM = true;
    float* Y; const float* res; const float* stin; const float* lg; const float* lb; float* stout; void* copy; float ascale, cscale;
    __device__ __forceinline__ void operator()(EPI_ARGS) const {
        const int row0 = u.pm * BM + wr * 64 + fr, col0 = u.pn * BM + wc * 32 + 8 * fq;
        f32x4 gg[2][2], bb[2][2];
        if constexpr (RESLN) {
#pragma unroll
            for (int bj = 0; bj < 2; ++bj)
#pragma unroll
                for (int n = 0; n < 2; ++n) { gg[bj][n] = *(const f32x4*)(lg + col0 + bj * HALF + 4 * n); bb[bj][n] = *(const f32x4*)(lb + col0 + bj * HALF + 4 * n); } }
#pragma unroll
        for (int ai = 0; ai < 2; ++ai)
#pragma unroll
            for (int m = 0; m < 4; ++m) { const int row = row0 + ai * HALF + m * 16; const size_t off = (size_t)row * DM + col0;
                float mu = 0.f, rs = 1.f; if constexpr (RESLN) ln_stats(stin, row, mu, rs);
                float ss = 0.f, qq = 0.f;
#pragma unroll
                for (int bj = 0; bj < 2; ++bj) { f32x4 r0 = __builtin_nontemporal_load((const f32x4*)(res + off + bj * HALF)), r1 = __builtin_nontemporal_load((const f32x4*)(res + off + bj * HALF + 4));
                    if constexpr (RESLN) { r0 = (r0 - mu) * rs * gg[bj][0] + bb[bj][0]; r1 = (r1 - mu) * rs * gg[bj][1] + bb[bj][1]; }
                    const f32x4 y0 = r0 * DN_ALPHA + acc[ai][bj][m][0] * ascale, y1 = r1 * DN_ALPHA + acc[ai][bj][m][1] * ascale;
                    if constexpr (COPY != 4) { __builtin_nontemporal_store(y0, (f32x4*)(Y + off + bj * HALF)); __builtin_nontemporal_store(y1, (f32x4*)(Y + off + bj * HALF + 4)); }
                    if constexpr (STATS) { ss += ((y0[0] + y0[1]) + (y0[2] + y0[3])) + ((y1[0] + y1[1]) + (y1[2] + y1[3]));
                        qq += ((y0[0] * y0[0] + y0[1] * y0[1]) + (y0[2] * y0[2] + y0[3] * y0[3])) + ((y1[0] * y1[0] + y1[1] * y1[1]) + (y1[2] * y1[2] + y1[3] * y1[3])); }
                    if constexpr (COPY == 1) *(u32x2*)((unsigned char*)copy + off + bj * HALF) = pack8fp8(y0 * cscale, y1 * cscale);
                    if constexpr (COPY == 3) *(u32x2*)((unsigned char*)copy + off + bj * HALF) = pack8i8(y0 * cscale, y1 * cscale);
                    if constexpr (COPY == 2 || COPY == 4) *(u32x4*)((bf16_t*)copy + off + bj * HALF) = pack8bf(y0, y1); }
                if constexpr (STATS) { ss += __shfl_xor(ss, 16); ss += __shfl_xor(ss, 32); qq += __shfl_xor(qq, 16); qq += __shfl_xor(qq, 32);
                    if (fq == 0) { unsafeAtomicAdd(stout + 2 * (size_t)row, ss); unsafeAtomicAdd(stout + 2 * (size_t)row + 1, qq); } }
                asm volatile("" ::: "memory"); }
    }
};
template <bool F8OUT, bool FOLD, bool PRE = false> struct EpiSwiGLU {
    static constexpr bool PERM = true;
    void* O; int ldc; float ascale, oscale; const float* st; const float* C; const float* D;
    __device__ __forceinline__ float qscale(const Unit&) const { return 1.0f; }
    __device__ __forceinline__ void operator()(EPI_ARGS) const {
        const int row0 = u.pm * BM + wr * 64 + fr, col0 = u.pn * HALF + wc * 32 + 8 * fq, n0 = u.pn * BM + wc * 32 + 8 * fq;
        f32x4 cg[2], dg[2], cu[2], du[2];
        if constexpr (FOLD) {
#pragma unroll
            for (int n = 0; n < 2; ++n) { cg[n] = *(const f32x4*)(C + n0 + 4 * n); dg[n] = *(const f32x4*)(D + n0 + 4 * n); cu[n] = *(const f32x4*)(C + n0 + HALF + 4 * n); du[n] = *(const f32x4*)(D + n0 + HALF + 4 * n);
                if constexpr (PRE) { float os_ = oscale; asm volatile("" : "+s"(os_)); cu[n] = cu[n] * os_; du[n] = du[n] * os_; } } }
#pragma unroll
        for (int ai = 0; ai < 2; ++ai)
#pragma unroll
            for (int m = 0; m < 4; ++m) { const int row = row0 + ai * HALF + m * 16; f32x4 r[2];
                float mu = 0.f, rs = 1.f; if constexpr (FOLD) ln_stats(st, row, mu, rs);
#pragma unroll
                for (int n = 0; n < 2; ++n) { f32x4 g = acc[ai][0][m][n], up = acc[ai][1][m][n];
                    if constexpr (!PRE) { g = g * ascale; up = up * ascale; }
                    if constexpr (FOLD) { g = (g - cg[n] * mu) * rs + dg[n]; up = (up - cu[n] * mu) * rs + du[n]; }
                    if constexpr (!PRE) up = up * oscale;
#pragma unroll
                    for (int j = 0; j < 4; ++j) { const float e = __builtin_amdgcn_exp2f(g[j] * -1.4426950408889634f); r[n][j] = g[j] * __builtin_amdgcn_rcpf(1.0f + e) * up[j]; } }
                if constexpr (F8OUT) *(u32x2*)((unsigned char*)O + (size_t)row * ldc + col0) = pack8fp8(r[0], r[1]);
                else *(u32x4*)((bf16_t*)O + (size_t)row * ldc + col0) = pack8bf(r[0], r[1]); }
    }
};
struct EpiBf16 {
    static constexpr bool PERM = true;
    bf16_t* O; int ldc; int rowoff; size_t bufstride; float ascale;
    float f8;
    __device__ __forceinline__ void operator()(EPI_ARGS) const {
        const int row0 = u.pm * BM + wr * 64 + fr, col0 = u.pn * BM + wc * 32 + 8 * fq;
#pragma unroll
        for (int ai = 0; ai < 2; ++ai)
#pragma unroll
            for (int m = 0; m < 4; ++m) { const size_t eo = (size_t)u.buf * bufstride + (size_t)(row0 - rowoff + ai * HALF + m * 16) * ldc + col0;
                if (f8 < 0.f) { const float s8 = ascale * -f8;
#pragma unroll
                    for (int bj = 0; bj < 2; ++bj) { u32x2 w = pack8i8(acc[ai][bj][m][0] * s8, acc[ai][bj][m][1] * s8); w.x ^= 0x80808080u; w.y ^= 0x80808080u; *(u32x2*)((unsigned char*)O + eo + bj * HALF) = w; } }
                else if (f8 != 0.f) { const float s8 = ascale * f8;
#pragma unroll
                    for (int bj = 0; bj < 2; ++bj) *(u32x2*)((unsigned char*)O + eo + bj * HALF) = pack8fp8(acc[ai][bj][m][0] * s8, acc[ai][bj][m][1] * s8); }
                else {
#pragma unroll
                for (int bj = 0; bj < 2; ++bj) *(u32x4*)(O + eo + bj * HALF) = pack8bf(acc[ai][bj][m][0] * ascale, acc[ai][bj][m][1] * ascale); } }
    }
};
struct EpiMlaDown {
    static constexpr bool PERM = true;
    bf16_t* CQ; bf16_t* CKV; bf16_t* KPE; float* ssq; const float* cs; const float* sn; const float* st; const float* C; const float* D;
    float lsc;
    __device__ __forceinline__ float qscale(const Unit&) const { return 1.0f; }
    __device__ __forceinline__ void operator()(EPI_ARGS) const {
        const int row0 = u.pm * BM + wr * 64 + fr, n0 = u.pn * BM + wc * 32 + 8 * fq;
        if (u.pn < 4) {
            bf16_t* dst = (u.pn < 2) ? CQ : CKV; const int col0 = (u.pn & 1) * BM + wc * 32 + 8 * fq; const int slot = (u.pn >> 1) * 8 + (u.pn & 1) * 4 + wc;
            f32x4 cc[2][2], dd[2][2];
#pragma unroll
            for (int bj = 0; bj < 2; ++bj)
#pragma unroll
                for (int n = 0; n < 2; ++n) { cc[bj][n] = *(const f32x4*)(C + n0 + bj * HALF + 4 * n); dd[bj][n] = *(const f32x4*)(D + n0 + bj * HALF + 4 * n); }
#pragma unroll
            for (int ai = 0; ai < 2; ++ai)
#pragma unroll
                for (int m = 0; m < 4; ++m) { const int row = row0 + ai * HALF + m * 16; float s = 0.f; float mu, rs; ln_stats(st, row, mu, rs);
#pragma unroll
                    for (int bj = 0; bj < 2; ++bj) { const f32x4 a = (acc[ai][bj][m][0] - cc[bj][0] * mu) * rs + dd[bj][0], b = (acc[ai][bj][m][1] - cc[bj][1] * mu) * rs + dd[bj][1];
                        s += (a[0] * a[0] + a[1] * a[1]) + (a[2] * a[2] + a[3] * a[3]) + (b[0] * b[0] + b[1] * b[1]) + (b[2] * b[2] + b[3] * b[3]);
                        *(u32x2*)((unsigned char*)dst + (size_t)row * 512 + col0 + bj * HALF) = pack8i8(a * lsc, b * lsc); }
                    s += __shfl_xor(s, 16); s += __shfl_xor(s, 32);
                    if (fq == 0) ssq[(size_t)row * 16 + slot] = s; }
        } else if (wc < 2) {
            const int fi = 16 * wc + 4 * fq;
            const f32x4 c0 = *(const f32x4*)(C + n0), c1 = *(const f32x4*)(C + n0 + 4), d0 = *(const f32x4*)(D + n0), d1 = *(const f32x4*)(D + n0 + 4);
#pragma unroll
            for (int ai = 0; ai < 2; ++ai)
#pragma unroll
                for (int m = 0; m < 4; ++m) { const int row = row0 + ai * HALF + m * 16; float mu, rs; ln_stats(st, row, mu, rs);
                    const f32x4 c4 = *(const f32x4*)(cs + (size_t)row * 32 + fi), s4 = *(const f32x4*)(sn + (size_t)row * 32 + fi);
                    const f32x4 v0 = (acc[ai][0][m][0] - c0 * mu) * rs + d0, v1 = (acc[ai][0][m][1] - c1 * mu) * rs + d1;
                    *(u32x2*)((unsigned char*)KPE + (size_t)row * 64 + 32 * (fq & 1) + 8 * (2 * wc + (fq >> 1))) = pack8fp8(v0 * c4 - v1 * s4, v1 * c4 + v0 * s4); }
        }
    }
};
struct EpiKpe {
    static constexpr bool PERM = true;
    bf16_t* KPE; const float* cs; const float* sn; const float* st; const float* C; const float* D;
    __device__ __forceinline__ float qscale(const Unit&) const { return 1.0f; }
    __device__ __forceinline__ void operator()(EPI_ARGS) const {
        if (wc >= 2) return;
        const int row0 = u.pm * BM + wr * 64 + fr, n0 = 1024 + wc * 32 + 8 * fq, fi = 16 * wc + 4 * fq;
        const f32x4 c0 = *(const f32x4*)(C + n0), c1 = *(const f32x4*)(C + n0 + 4), d0 = *(const f32x4*)(D + n0), d1 = *(const f32x4*)(D + n0 + 4);
#pragma unroll
        for (int ai = 0; ai < 2; ++ai)
#pragma unroll
            for (int m = 0; m < 4; ++m) { const int row = row0 + ai * HALF + m * 16; float mu, rs; ln_stats(st, row, mu, rs);
                const f32x4 c4 = *(const f32x4*)(cs + (size_t)row * 32 + fi), s4 = *(const f32x4*)(sn + (size_t)row * 32 + fi);
                const f32x4 v0 = (acc[ai][0][m][0] - c0 * mu) * rs + d0, v1 = (acc[ai][0][m][1] - c1 * mu) * rs + d1;
                *(u32x2*)((unsigned char*)KPE + (size_t)row * 64 + 32 * (fq & 1) + 8 * (2 * wc + (fq >> 1))) = pack8fp8(v0 * c4 - v1 * s4, v1 * c4 + v0 * s4); }
    }
};
__device__ __forceinline__ float rms_scale(const float* ssq, int row, int which) {
    const f32x4 a = *(const f32x4*)(ssq + (size_t)row * 16 + which * 8), b = *(const f32x4*)(ssq + (size_t)row * 16 + which * 8 + 4);
    const float s = ((a[0] + a[1]) + (a[2] + a[3])) + ((b[0] + b[1]) + (b[2] + b[3]));
    return 1.0f / sqrtf(s * (1.0f / 512.0f) + RMS_EPS);
}
struct EpiMlaQ {
    static constexpr bool PERM = true;
    bf16_t* Q; const float* ssq; const float* cs; const float* sn;
    __device__ __forceinline__ float qscale(const Unit&) const { return 1.0f; }
    __device__ __forceinline__ void operator()(EPI_ARGS) const {
        const int row0 = u.pm * BM + wr * 64 + fr;
#pragma unroll
        for (int ai = 0; ai < 2; ++ai)
#pragma unroll
            for (int m = 0; m < 4; ++m) { const int row = row0 + ai * HALF + m * 16; const float rs = rms_scale(ssq, row, 0);
                if (u.pn < 8) {
#pragma unroll
                    for (int bj = 0; bj < 2; ++bj) { const int h = 2 * u.pn + bj;
                        *(u32x4*)(Q + ((size_t)h * NTOK + row) * 192 + 32 * wc + 8 * fq) = pack8bf(acc[ai][bj][m][0] * rs, acc[ai][bj][m][1] * rs); }
                } else { const int fi = 16 * (wc & 1) + 4 * fq;
                    const f32x4 c4 = *(const f32x4*)(cs + (size_t)row * 32 + fi), s4 = *(const f32x4*)(sn + (size_t)row * 32 + fi);
#pragma unroll
                    for (int bj = 0; bj < 2; ++bj) { const int h = 4 * (u.pn - 8) + 2 * bj + (wc >> 1); const f32x4 v0 = acc[ai][bj][m][0] * rs, v1 = acc[ai][bj][m][1] * rs;
                        *(u32x4*)(Q + ((size_t)h * NTOK + row) * 192 + 128 + 32 * (wc & 1) + 8 * fq) = pack8bf(v0 * c4 - v1 * s4, v1 * c4 + v0 * s4); } }
            }
    }
};
struct EpiMlaKV {
    static constexpr bool PERM = true;
    bf16_t* KN; bf16_t* V; const float* ssq;
    __device__ __forceinline__ float qscale(const Unit& u) const { return u.pn >= 8 ? 0.5f : 1.0f; }
    __device__ __forceinline__ void operator()(EPI_ARGS) const {
        const int row0 = u.pm * BM + wr * 64 + fr; bf16_t* dst = (u.pn < 8) ? KN : V; const int h0 = 2 * (u.pn & 7);
#pragma unroll
        for (int ai = 0; ai < 2; ++ai)
#pragma unroll
            for (int m = 0; m < 4; ++m) { const int row = row0 + ai * HALF + m * 16; const float rs = rms_scale(ssq, row, 1);
#pragma unroll
                for (int bj = 0; bj < 2; ++bj)
                    *(u32x2*)((unsigned char*)dst + ((size_t)(h0 + bj) * NTOK + row) * 128 + 64 * (wc >> 1) + 32 * (fq & 1) + 8 * ((2 * wc + (fq >> 1)) & 3)) = pack8fp8(acc[ai][bj][m][0] * rs, acc[ai][bj][m][1] * rs); }
    }
};
struct EpiMlaVT {
    static constexpr bool PERM = true;
    unsigned char* VT; const float* ssq; float osc;
    __device__ __forceinline__ float qscale(const Unit&) const { return 1.0f; }
    __device__ __forceinline__ void operator()(EPI_ARGS) const {
        const int dcol = 32 * wc + 8 * (fr >> 2) + (fr & 3);
#pragma unroll
        for (int ai = 0; ai < 2; ++ai)
#pragma unroll
            for (int m = 0; m < 4; ++m) { const int t0 = u.pm * BM + ai * HALF + wr * 64 + 16 * m + 4 * fq, q = 4 * m + fq;
                const f32x4 rs = (f32x4){rms_scale(ssq, t0, 1), rms_scale(ssq, t0 + 1, 1), rms_scale(ssq, t0 + 2, 1), rms_scale(ssq, t0 + 3, 1)} * osc;
                const size_t tpos = (size_t)(t0 & ~63) + 32 * (q & 1) + 16 * (q >> 3) + 4 * ((q >> 1) & 3);
#pragma unroll
                for (int bj = 0; bj < 2; ++bj)
#pragma unroll
                    for (int n = 0; n < 2; ++n) { const f32x4 v = acc[ai][bj][m][n] * rs;
                        int w = __builtin_amdgcn_cvt_pk_fp8_f32(clamp448(v[0]), clamp448(v[1]), 0, false); w = __builtin_amdgcn_cvt_pk_fp8_f32(clamp448(v[2]), clamp448(v[3]), w, true);
                        *(unsigned*)(VT + ((size_t)((2 * u.pn + bj) * 128 + dcol + 4 * n)) * NTOK + tpos) = (unsigned)w; } }
    }
};
}
namespace att {
constexpr int NW = 8, QBLK = 32, KVBLK = 64, QB = NW * QBLK, D = 128;
constexpr int SHM_V = KVBLK * D * 2, SHM_K = KVBLK * D * 2, KP_PITCH = 144, SHM_KP = KVBLK * KP_PITCH;
constexpr int OFF_V = 0, OFF_K = 2 * SHM_V, OFF_WS = OFF_K + 2 * SHM_K, OFF_KP = OFF_WS + NW * 64 * 4, OFF_CUM = OFF_KP + 2 * SHM_KP, OFF_QPE = OFF_CUM  , LDS_BYTES = OFF_QPE + 49152;
template <int MODE> struct Cfg;
template <> struct Cfg<0> { static constexpr bool F8PV = false; static constexpr float THR = 8.f; static constexpr bool F8QK = false; static constexpr int NQR = 8; static constexpr int DK = 128; static constexpr bool BIAS = true,  SK = false, KP = false; static constexpr float SCALE = 0.08838834764831845f; };
template <> struct Cfg<1> { static constexpr bool F8PV = false; static constexpr float THR = 8.f; static constexpr bool F8QK = false; static constexpr int NQR = 8; static constexpr int DK = 128; static constexpr bool BIAS = false, SK = true,  KP = false; static constexpr float SCALE = 0.08838834764831845f; };
template <> struct Cfg<2> { static constexpr bool F8PV = true;  static constexpr float THR = 6.f; static constexpr bool F8QK = true;  static constexpr int NQR = 6; static constexpr int DK = 192; static constexpr bool BIAS = false, SK = false, KP = true;  static constexpr float SCALE = 0.07216878364870323f; };

#define KSWZ(row, colB) ((row) * 256 + ((colB) ^ (((row) & 7) << 4)))
#define SBAR() __builtin_amdgcn_sched_barrier(0)
__device__ __forceinline__ int v_st(int k, int c) { const int kk = (k & ~0xC) | ((k & 4) << 1) | ((k & 8) >> 1); return ((kk >> 3) * 4 + (c >> 5)) * 512 + ((kk & 7) * 32 + (c & 31)) * 2; }
__device__ __forceinline__ int v_rd_base(int lane) { return ((lane & 3) << 3) | (((lane >> 2) & 3) << 6) | (((lane >> 4) & 1) << 5) | (((lane >> 5) & 1) << 8); }
constexpr int v_rd_off(int d0, int ks, int half) { return d0 * 512 + ks * 4096 + half * 2048; }
__device__ __forceinline__ int crow(int r, int hi) { return (r & 3) + 8 * (r >> 2) + 4 * hi; }
__device__ __forceinline__ bf16x8 load8(const bf16_t* p) { return *reinterpret_cast<const bf16x8*>(p); }
typedef int v8i_t __attribute__((ext_vector_type(8)));
constexpr int K8P = 208;
__device__ __forceinline__ u32x2 bf8_to_fp8(const bf16x8 v, const float f = 1.0f) {
    const u32x4 w = __builtin_bit_cast(u32x4, v);
    int lo = __builtin_amdgcn_cvt_pk_fp8_f32(__uint_as_float(w[0] << 16) * f, __uint_as_float(w[0] & 0xffff0000u) * f, 0, false); lo = __builtin_amdgcn_cvt_pk_fp8_f32(__uint_as_float(w[1] << 16) * f, __uint_as_float(w[1] & 0xffff0000u) * f, lo, true);
    int hi = __builtin_amdgcn_cvt_pk_fp8_f32(__uint_as_float(w[2] << 16) * f, __uint_as_float(w[2] & 0xffff0000u) * f, 0, false); hi = __builtin_amdgcn_cvt_pk_fp8_f32(__uint_as_float(w[3] << 16) * f, __uint_as_float(w[3] & 0xffff0000u) * f, hi, true);
    return (u32x2){(unsigned)lo, (unsigned)hi}; }

__device__ __forceinline__ void mask_tile(f32x16& p0, f32x16& p1, int dq, unsigned W) {
    const float NEG = -__builtin_inff();
#pragma unroll
    for (int r = 0; r < 16; ++r) {
        const int c = (r & 3) + 8 * (r >> 2);
        if ((unsigned)(dq - c) >= W) p0[r] = NEG;
        if ((unsigned)(dq - c - 32) >= W) p1[r] = NEG;
    }
}
template <int MODE>
__device__ __forceinline__ void partialSM(f32x16& p0, f32x16& p1, float& m_reg, float& mn, float& alpha, const bool first) {
    constexpr float SCALE = Cfg<MODE>::SCALE;
    if constexpr (Cfg<MODE>::F8QK) {
        float pmax = p0[0]; for (int r = 1; r < 16; ++r) pmax = fmaxf(pmax, p0[r]); for (int r = 0; r < 16; ++r) pmax = fmaxf(pmax, p1[r]);
        { auto rr = __builtin_amdgcn_permlane32_swap(__float_as_uint(pmax), __float_as_uint(pmax), false, false);
          pmax = fmaxf(__uint_as_float(rr[0]), __uint_as_float(rr[1])); }
        constexpr float THR2 = Cfg<MODE>::THR * 1.4426950408889634f;
        if (__builtin_expect(!first && __all(pmax <= THR2), 1)) { mn = m_reg; alpha = 1.f; }
        else { const float moff = first ? 0.f : m_reg; mn = fmaxf(m_reg, moff + pmax); alpha = __builtin_amdgcn_exp2f(m_reg - mn); m_reg = mn; const float d = mn - moff;
            for (int r = 0; r < 16; ++r) p0[r] -= d; for (int r = 0; r < 16; ++r) p1[r] -= d; }
        for (int r = 0; r < 16; ++r) p0[r] = __builtin_amdgcn_exp2f(p0[r]);
        return; }
    float pmax = p0[0]; for (int r = 1; r < 16; ++r) pmax = fmaxf(pmax, p0[r]); for (int r = 0; r < 16; ++r) pmax = fmaxf(pmax, p1[r]);
    { auto rr = __builtin_amdgcn_permlane32_swap(__float_as_uint(pmax), __float_as_uint(pmax), false, false);
      pmax = fmaxf(__uint_as_float(rr[0]), __uint_as_float(rr[1])); }
    constexpr float C2 = 1.4426950408889634f * SCALE;
    if (__builtin_expect(__all((pmax - m_reg) * SCALE <= Cfg<MODE>::THR), 1)) { mn = m_reg; alpha = 1.f; }
    else { mn = fmaxf(m_reg, pmax); alpha = __builtin_amdgcn_exp2f((m_reg - mn) * C2); m_reg = mn; }
    const float mnL = -mn * C2;
    for (int r = 0; r < 16; ++r) p0[r] = fmaf(p0[r], C2, mnL); for (int r = 0; r < 16; ++r) p1[r] = fmaf(p1[r], C2, mnL);
    for (int r = 0; r < 16; ++r) p0[r] = __builtin_amdgcn_exp2f(p0[r]);
}
__device__ __forceinline__ void finishSM(f32x16& p0, f32x16& p1, float alpha, float& l_reg, bf16x8& pa0, bf16x8& pa1, bf16x8& pa2, bf16x8& pa3) {
    for (int r = 0; r < 16; ++r) p1[r] = __builtin_amdgcn_exp2f(p1[r]);
    float ps = 0; for (int r = 0; r < 16; ++r) ps += p0[r]; for (int r = 0; r < 16; ++r) ps += p1[r];
    { auto rr = __builtin_amdgcn_permlane32_swap(__float_as_uint(ps), __float_as_uint(ps), false, false);
      ps = __uint_as_float(rr[0]) + __uint_as_float(rr[1]); }
    l_reg = l_reg * alpha + ps;
#define PK4(P, B_, OUT) do { unsigned a0 = cvt_pk_bf16(P[B_+0], P[B_+1]), a1 = cvt_pk_bf16(P[B_+2], P[B_+3]);                          \
        unsigned b0 = cvt_pk_bf16(P[B_+4], P[B_+5]), b1 = cvt_pk_bf16(P[B_+6], P[B_+7]);                                             \
        auto r0 = __builtin_amdgcn_permlane32_swap(a0, b0, false, false); auto r1 = __builtin_amdgcn_permlane32_swap(a1, b1, false, false); \
        u32x4 w = {r0[0], r1[0], r0[1], r1[1]}; OUT = *reinterpret_cast<bf16x8*>(&w); } while (0)
    PK4(p0, 0, pa0); PK4(p0, 8, pa1); PK4(p1, 0, pa2); PK4(p1, 8, pa3);
#undef PK4
}
constexpr int VP8 = 80;
__device__ __forceinline__ void finishSM8(f32x16& p0, f32x16& p1, float alpha, float& l_reg, v8i_t& pf) {
    for (int r = 0; r < 16; ++r) p1[r] = __builtin_amdgcn_exp2f(p1[r]);
    float ps = 0; for (int r = 0; r < 16; ++r) ps += p0[r]; for (int r = 0; r < 16; ++r) ps += p1[r];
    { auto rr = __builtin_amdgcn_permlane32_swap(__float_as_uint(ps), __float_as_uint(ps), false, false);
      ps = __uint_as_float(rr[0]) + __uint_as_float(rr[1]); }
    l_reg = l_reg * alpha + ps;
#pragma unroll
    for (int j = 0; j < 4; ++j) { int w = __builtin_amdgcn_cvt_pk_fp8_f32(p0[4 * j], p0[4 * j + 1], 0, false); w = __builtin_amdgcn_cvt_pk_fp8_f32(p0[4 * j + 2], p0[4 * j + 3], w, true); pf[j] = w;
        int x = __builtin_amdgcn_cvt_pk_fp8_f32(p1[4 * j], p1[4 * j + 1], 0, false); x = __builtin_amdgcn_cvt_pk_fp8_f32(p1[4 * j + 2], p1[4 * j + 3], x, true); pf[4 + j] = x; }
}
__device__ __forceinline__ void pv_tile8(f32x16* o, const char* vrt, int r32, int hi, const v8i_t pf) {
    const char* vb = vrt + r32 * VP8 + hi * 32; const int sc1 = 0x7F7F7F7F;
#pragma unroll
    for (int d0 = 0; d0 < 4; ++d0) { const u32x4 a0 = *reinterpret_cast<const u32x4*>(vb + d0 * 32 * VP8), a1 = *reinterpret_cast<const u32x4*>(vb + d0 * 32 * VP8 + 16);
        const v8i_t vf = (v8i_t){(int)a0[0], (int)a0[1], (int)a0[2], (int)a0[3], (int)a1[0], (int)a1[1], (int)a1[2], (int)a1[3]};
        asm volatile("v_mfma_scale_f32_32x32x64_f8f6f4 %0, %1, %2, %0, %3, %3 op_sel_hi:[0,0,0]" : "+v"(o[d0]) : "v"(pf), "v"(vf), "v"(sc1)); }
}
template <int MODE, int KB, bool PAD = false>
__device__ __forceinline__ void qkt(f32x16& p0, f32x16& p1, const char* K_lds, const char* KP_lds, int r32, int hi, const bf16x8* qr, const v8i_t* q8, bool act, const float* ck, float cq, const char* qpe, const float minit, const char* krt = nullptr) {
    constexpr bool SK = Cfg<MODE>::SK;
    if constexpr (Cfg<MODE>::F8QK) {
        const float ni_ = -minit; const int sc1 = 0x7F7F7F7F, scq = 0x7C7C7C7C;
#pragma unroll
        for (int r = 0; r < 16; ++r) { p0[r] = ni_; p1[r] = ni_; }
        const char* k0 = krt + r32 * K8P + hi * 32;
#pragma unroll
        for (int s = 0; s < 3; ++s) {
            const u32x4 a0 = *reinterpret_cast<const u32x4*>(k0 + 64 * s), a1 = *reinterpret_cast<const u32x4*>(k0 + 64 * s + 16);
            const u32x4 b0 = *reinterpret_cast<const u32x4*>(k0 + 32 * K8P + 64 * s), b1 = *reinterpret_cast<const u32x4*>(k0 + 32 * K8P + 64 * s + 16);
            const v8i_t ka = (v8i_t){(int)a0[0], (int)a0[1], (int)a0[2], (int)a0[3], (int)a1[0], (int)a1[1], (int)a1[2], (int)a1[3]}, kb2 = (v8i_t){(int)b0[0], (int)b0[1], (int)b0[2], (int)b0[3], (int)b1[0], (int)b1[1], (int)b1[2], (int)b1[3]};
            asm volatile("v_mfma_scale_f32_32x32x64_f8f6f4 %0, %1, %2, %0, %3, %4 op_sel_hi:[0,0,0]" : "+v"(p0) : "v"(ka), "v"(q8[s]), "v"(sc1), "v"(scq));
            asm volatile("v_mfma_scale_f32_32x32x64_f8f6f4 %0, %1, %2, %0, %3, %4 op_sel_hi:[0,0,0]" : "+v"(p1) : "v"(kb2), "v"(q8[s]), "v"(sc1), "v"(scq)); }
        if constexpr (PAD) asm volatile("s_nop 15\n\ts_nop 15" : "+v"(p0), "+v"(p1));
        return; }
    if (SK && !act) { const float NEG = -__builtin_inff();
#pragma unroll
        for (int r = 0; r < 16; ++r) { p0[r] = NEG; p1[r] = NEG; } return; }
    if constexpr (Cfg<MODE>::BIAS) {
        const f32x4* c4 = reinterpret_cast<const f32x4*>(ck + 4 * hi);
#pragma unroll
        for (int g = 0; g < 4; ++g) { const f32x4 a = c4[2 * g], b = c4[2 * g + 8];
#pragma unroll
            for (int j = 0; j < 4; ++j) { p0[4 * g + j] = a[j]; p1[4 * g + j] = b[j]; } }
    } else { p0 = f32x16{}; p1 = f32x16{}; }
    const char* kb[4];
#pragma unroll
    for (int dd = 0; dd < 4; ++dd) kb[dd] = K_lds + KB * SHM_K + KSWZ(r32, (dd * 16 + hi * 8) * 2);
#pragma unroll
    for (int d0 = 0; d0 < 8; ++d0) { const char* a = kb[d0 & 3] + (d0 >> 2) * 128;
        bf16x8 b0 = *reinterpret_cast<const bf16x8*>(a);
        bf16x8 b1 = *reinterpret_cast<const bf16x8*>(a + 32 * 256);
        bf16x8 qf; if (d0 < Cfg<MODE>::NQR) qf = qr[d0]; else qf = *reinterpret_cast<const bf16x8*>(qpe + (d0 - Cfg<MODE>::NQR) * 1024);
        p0 = __builtin_amdgcn_mfma_f32_32x32x16_bf16(b0, qf, p0, 0, 0, 0);
        p1 = __builtin_amdgcn_mfma_f32_32x32x16_bf16(b1, qf, p1, 0, 0, 0); }
    if constexpr (Cfg<MODE>::KP) {
        const char* kp = KP_lds + KB * SHM_KP + r32 * KP_PITCH + hi * 16;
#pragma unroll
        for (int j = 0; j < 4; ++j) {
            bf16x8 b0 = *reinterpret_cast<const bf16x8*>(kp + j * 32);
            bf16x8 b1 = *reinterpret_cast<const bf16x8*>(kp + j * 32 + 32 * KP_PITCH);
            const bf16x8 qf = *reinterpret_cast<const bf16x8*>(qpe + (8 - Cfg<MODE>::NQR + j) * 1024);
            p0 = __builtin_amdgcn_mfma_f32_32x32x16_bf16(b0, qf, p0, 0, 0, 0);
            p1 = __builtin_amdgcn_mfma_f32_32x32x16_bf16(b1, qf, p1, 0, 0, 0); }
    }
}
template <int VB, bool SK>
__device__ __forceinline__ void pv_tile(f32x16* o, int vb0, bf16x8 pa0, bf16x8 pa1, bf16x8 pa2, bf16x8 pa3, bool act) {
    if (SK && !act) return;
#define TRRD(dst, off) asm volatile("ds_read_b64_tr_b16 %0, %1 offset:%2" : "=&v"(dst) : "v"(vb0), "i"(off) : "memory")
#define PV_D0(d0) do { s16x4 l0, l1, l2, l3, h0, h1, h2, h3; constexpr int b_ = OFF_V + VB * SHM_V + v_rd_off(d0, 0, 0); \
        TRRD(l0, b_); TRRD(h0, b_ + 2048); TRRD(l1, b_ + 4096); TRRD(h1, b_ + 6144); TRRD(l2, b_ + 8192); TRRD(h2, b_ + 10240); TRRD(l3, b_ + 12288); TRRD(h3, b_ + 14336); \
        asm volatile("s_waitcnt lgkmcnt(0)" ::: "memory"); SBAR();   \
        o[d0] = __builtin_amdgcn_mfma_f32_32x32x16_bf16(pa0, (bf16x8){l0[0], l0[1], l0[2], l0[3], h0[0], h0[1], h0[2], h0[3]}, o[d0], 0, 0, 0);   \
        o[d0] = __builtin_amdgcn_mfma_f32_32x32x16_bf16(pa1, (bf16x8){l1[0], l1[1], l1[2], l1[3], h1[0], h1[1], h1[2], h1[3]}, o[d0], 0, 0, 0);   \
        o[d0] = __builtin_amdgcn_mfma_f32_32x32x16_bf16(pa2, (bf16x8){l2[0], l2[1], l2[2], l2[3], h2[0], h2[1], h2[2], h2[3]}, o[d0], 0, 0, 0);   \
        o[d0] = __builtin_amdgcn_mfma_f32_32x32x16_bf16(pa3, (bf16x8){l3[0], l3[1], l3[2], l3[3], h3[0], h3[1], h3[2], h3[3]}, o[d0], 0, 0, 0); } while (0)
    PV_D0(0); PV_D0(1); PV_D0(2); PV_D0(3);
#undef PV_D0
#undef TRRD
}

struct BlockRef { int qrow, kvrow, kprow, orow, hcol, P0, jlo; float m0, l0; };
struct AttnArgs { const bf16_t* Q; const bf16_t* K; const bf16_t* V; const bf16_t* KP; bf16_t* O; const float* cum; const float* sinks; int nh, nhkv, W, ldo; const float* nrm; float o8 = 0.f; };
template <int MODE> struct Seam { bf16x8 qr[Cfg<MODE>::DK / 16]; bf16x8 st_v0, st_v1, st_k0, st_k1, st_kp; int b0; };
__device__ __forceinline__ int swa_jlo(int P0, int W) { const int lowk = P0 - W + 1; return lowk > 0 ? lowk / KVBLK : 0; }
#define ROW(p, k0, rr) ((p) + (size_t)((k0) + (rr)) * D + sc)
#define VMW() asm volatile("s_waitcnt vmcnt(0)" ::: "memory")
#define VMWN(n) asm volatile("s_waitcnt vmcnt(%0)" :: "i"(n) : "memory")
#define KBASE8(kvrow_) (C::F8QK ? (const bf16_t*)((const char*)a.K + (size_t)(kvrow_) * 128) : a.K + (size_t)(kvrow_) * D)
#define KPBASE8(kprow_) (C::F8QK ? (const bf16_t*)((const char*)a.KP + (size_t)(kprow_) * 64) : a.KP + (size_t)(kprow_) * 64)
#define VBASE(kvrow_, kprow_) (C::F8PV ? (const bf16_t*)((const char*)a.V + (size_t)((kvrow_) - (kprow_)) * 128 + (kprow_)) : a.V + (size_t)(kvrow_) * D)
#define SLOAD_H(Kp, Vp, KPp, k0) do { if constexpr (C::F8PV) { S.st_v0 = *(const bf16x8*)((const char*)(Vp) + (size_t)(2 * kr + (kc >> 2)) * NTOK + (k0) + 16 * (kc & 3)); }       \
                         else { S.st_v0 = load8(ROW(Vp, k0, sr)); S.st_v1 = load8(ROW(Vp, k0, 32 + sr)); }             \
                         if constexpr (C::F8QK) { S.st_k0 = *(const bf16x8*)((const char*)(Kp) + (size_t)((k0) + kr) * 128 + kc * 16);                                         \
                             if (kr < 32) S.st_kp = *(const bf16x8*)((const char*)(KPp) + (size_t)((k0) + 2 * kr + (kc >> 2)) * 64 + (kc & 3) * 16); }                          \
                         else { S.st_k0 = load8(ROW(Kp, k0, sr)); S.st_k1 = load8(ROW(Kp, k0, 32 + sr));                  \
                         if constexpr (C::KP) S.st_kp = load8((KPp) + (size_t)((k0) + kr) * 64 + kc * 8); } } while (0)
#define SWRITE_HK(bf) do { if constexpr (C::F8QK) { char* kb_ = K_lds + (bf) * SHM_K;       \
                           *(bf16x8*)(kb_ + kr * K8P + kc * 16) = S.st_k0; if (kr < 32) *(bf16x8*)(kb_ + (2 * kr + (kc >> 2)) * K8P + 128 + (kc & 3) * 16) = S.st_kp; } else {     \
                         *(bf16x8*)(K_lds + (bf) * SHM_K + kws) = S.st_k0; *(bf16x8*)(K_lds + (bf) * SHM_K + kws + 32 * 256) = S.st_k1; \
                         if constexpr (C::KP) *(bf16x8*)(KP_lds + (bf) * SHM_KP + kr * KP_PITCH + kc * 16) = S.st_kp; } } while (0)
#define SWRITE_HV(bf) do { if constexpr (C::F8PV) { *(bf16x8*)(V_lds + (bf) * SHM_V + (2 * kr + (kc >> 2)) * VP8 + (kc & 3) * 16) = S.st_v0; }                                   \
                         else { *(bf16x8*)(V_lds + (bf) * SHM_V + vst0) = S.st_v0; *(bf16x8*)(V_lds + (bf) * SHM_V + vst1) = S.st_v1; } } while (0)
#define SWRITE_H(bf) do { SWRITE_HV(bf); SWRITE_HK(bf); } while (0)
template <int MODE>
__device__ __forceinline__ void attn_prime(const AttnArgs& a, const BlockRef& cur, char* lds, Seam<MODE>& S, const int tid) {
    const int W = a.W;
    using C = Cfg<MODE>; constexpr int NQ = C::DK / 16;
    const int wid = __builtin_amdgcn_readfirstlane(tid >> 6), lane = tid & 63, r32 = lane & 31, hi = lane >> 5;
    const int sr = tid >> 4, sc = (tid & 15) * 8, kws = KSWZ(sr, sc * 2), kr = tid >> 3, kc = tid & 7; char* K_lds = lds + OFF_K; char* KP_lds = lds + OFF_KP;
    const int kb0 = cur.jlo * KVBLK; (void)W;
#pragma unroll
    for (int d0 = 0; d0 < NQ; ++d0) S.qr[d0] = load8(a.Q + (size_t)(cur.qrow + wid * QBLK + r32) * C::DK + d0 * 16 + hi * 8);
    SLOAD_H(KBASE8(cur.kvrow), VBASE(cur.kvrow, cur.kprow), KPBASE8(cur.kprow), kb0); VMW(); SWRITE_HK(0); S.b0 = 0;
    __syncthreads();
}
template <int MODE>
__device__ __forceinline__ void attn_block(const AttnArgs& a, const BlockRef& cur, const BlockRef& nxt, char* lds, Seam<MODE>& S, const int tid) {
    const int W = a.W, ldo = a.ldo;
    using C = Cfg<MODE>; constexpr int NQ = C::DK / 16; constexpr bool SK = C::SK; constexpr int NQR = C::NQR;
    const int wid = __builtin_amdgcn_readfirstlane(tid >> 6), lane = tid & 63, r32 = lane & 31, hi = lane >> 5;
    const int j_lo = cur.jlo;
    const int j_hi = (cur.P0 + QB - 1) / KVBLK + 1;
    const int NT = j_hi - j_lo;
    const int kbn = nxt.jlo * KVBLK;
    const int qlo = cur.P0 + wid * QBLK, qm = qlo + r32 - 4 * hi;
    char* V_lds = lds + OFF_V; char* K_lds = lds + OFF_K; char* KP_lds = lds + OFF_KP;
    float* ws = (float*)(lds + OFF_WS) + wid * 64; float* li_l = ws, * al_l = ws + 32;
    const float* cum_l = (const float*)(lds + OFF_CUM);
    char* qpe = lds + OFF_QPE + wid * 6144 + lane * 16;
    v8i_t q8[3];
    if constexpr (C::F8QK) {
        constexpr float QF = 8.0f * 1.4426950408889634f * C::SCALE;
#pragma unroll
        for (int s = 0; s < 3; ++s) { const u32x2 c0 = bf8_to_fp8(S.qr[4 * s], QF), c1 = bf8_to_fp8(S.qr[4 * s + 1], QF), c2 = bf8_to_fp8(S.qr[4 * s + 2], QF), c3 = bf8_to_fp8(S.qr[4 * s + 3], QF);
            q8[s] = (v8i_t){(int)c0.x, (int)c0.y, (int)c1.x, (int)c1.y, (int)c2.x, (int)c2.y, (int)c3.x, (int)c3.y}; } }
    else if constexpr (NQR < NQ) {
#pragma unroll
        for (int j = NQR; j < NQ; ++j) *(bf16x8*)(qpe + (j - NQR) * 1024) = S.qr[j]; }
    float m_reg = cur.m0, l_reg = cur.l0; f32x16 o[4] = {};
    const float cq = 0.f;
    const int sr = tid >> 4, sc = (tid & 15) * 8, vst0 = v_st(sr, sc), vst1 = v_st(32 + sr, sc), kws = KSWZ(sr, sc * 2), kr = tid >> 3, kc = tid & 7;
    const int vb0 = (int)(uintptr_t)lds + v_rd_base(lane);
    const bf16_t* Kh = KBASE8(cur.kvrow); const bf16_t* Vh = VBASE(cur.kvrow, cur.kprow); const bf16_t* KPh = KPBASE8(cur.kprow);
#define RESC(a) do { if (__any((a) < 1.f)) { if (hi == 0) al_l[r32] = (a); asm volatile("s_waitcnt lgkmcnt(0)" ::: "memory");              \
                     for (int d_ = 0; d_ < 4; ++d_) for (int r = 0; r < 16; ++r) o[d_][r] *= al_l[crow(r, hi)]; } } while (0)
#define KBASE(t) ((j_lo + (t)) * KVBLK)
#define ACT(t) (KBASE(t) <= qlo + QBLK - 1 && KBASE(t) + KVBLK - 1 >= qlo - W + 1)
#define MASKT(P0_, P1_, t) do { const int kb_ = KBASE(t); if ((!SK || ACT(t)) && (kb_ + KVBLK - 1 > qlo || kb_ <= qlo + QBLK - 1 - W)) mask_tile(P0_, P1_, qm - kb_, (unsigned)W); } while (0)
#define QKT(KB_, PX0, PX1, t) qkt<MODE, KB_>(PX0, PX1, K_lds, KP_lds, r32, hi, S.qr, q8, ACT(t), cum_l + KBASE(t), cq, qpe, m_reg, KB3(bq))
#define SEAM_K0() do { VMWN(NQR); if constexpr (C::F8QK) { const int nb_ = ((NT & 1) == 0) ? NX3(bq) : bq; char* kb_ = KB3(nb_);     \
                           *(bf16x8*)(kb_ + kr * K8P + kc * 16) = S.st_k0; if (kr < 32) *(bf16x8*)(kb_ + (2 * kr + (kc >> 2)) * K8P + 128 + (kc & 3) * 16) = S.st_kp; S.b0 = nb_; }  \
                       else SWRITE_HK(0); SBAR(); } while (0)
    f32x16 pA0, pA1, pB0, pB1; float mnA, mnB, alA, alB; bf16x8 pa0, pa1, pa2, pa3; v8i_t pf8;
    int bq = S.b0;
#define KB3(i) (lds + ((i) == 0 ? OFF_K : ((i) == 1 ? OFF_K + SHM_K : OFF_QPE)))
#define VB3(i) (lds + ((i) == 0 ? OFF_V : ((i) == 1 ? OFF_V + SHM_V : OFF_QPE + 16384)))
#define NX3(i) ((i) == 2 ? 0 : (i) + 1)
#define PR3(i) ((i) == 0 ? 2 : (i) - 1)
#define SWRITE3(i) do { char* kb_ = KB3(i); char* vb_ = VB3(i); *(bf16x8*)(vb_ + (2 * kr + (kc >> 2)) * VP8 + (kc & 3) * 16) = S.st_v0;                             \
                       *(bf16x8*)(kb_ + kr * K8P + kc * 16) = S.st_k0; if (kr < 32) *(bf16x8*)(kb_ + (2 * kr + (kc >> 2)) * K8P + 128 + (kc & 3) * 16) = S.st_kp; } while (0)
#define FIN(PY0, PY1, alY) do { if constexpr (C::F8PV) finishSM8(PY0, PY1, alY, l_reg, pf8); else finishSM(PY0, PY1, alY, l_reg, pa0, pa1, pa2, pa3); } while (0)
#define PV(VB_, act_) do { if constexpr (C::F8PV) pv_tile8(o, (VB_) == 0 ? VB3(PR3(bq)) : VB3(bq), r32, hi, pf8); else pv_tile<VB_, SK>(o, vb0, pa0, pa1, pa2, pa3, act_); } while (0)
#define PVPREV(VB_, act_) do { if constexpr (C::F8PV) pv_tile8(o, VB3(PR3(bq)), r32, hi, pf8); else pv_tile<VB_, SK>(o, vb0, pa0, pa1, pa2, pa3, act_); } while (0)
    if constexpr (C::F8PV) { *(bf16x8*)(VB3(bq) + (2 * kr + (kc >> 2)) * VP8 + (kc & 3) * 16) = S.st_v0; } else SWRITE_HV(0);
    SBAR();
    if (NT > 1) { SLOAD_H(Kh, Vh, KPh, KBASE(1)); }
    SBAR(); qkt<MODE, 0, true>(pA0, pA1, K_lds, KP_lds, r32, hi, S.qr, q8, ACT(0), cum_l + KBASE(0), cq, qpe, 0.f, KB3(bq));
    MASKT(pA0, pA1, 0); partialSM<MODE>(pA0, pA1, m_reg, mnA, alA, true);
    if (NT > 1) { VMW(); if constexpr (C::F8QK) SWRITE3(NX3(bq)); else SWRITE_H(1); }
    if constexpr (C::F8QK) bq = NX3(bq);
    __syncthreads();
#define HALF_STEP(PX0, PX1, mnX, alX, PY0, PY1, alY, t, KB, VB, SB) do {                                                      \
        SBAR(); QKT(KB, PX0, PX1, t);                                                                                         \
        FIN(PY0, PY1, alY); SBAR();                                                                                           \
        if ((t) + 1 < NT) { SLOAD_H(Kh, Vh, KPh, KBASE((t) + 1)); SBAR(); }                                                   \
        PVPREV(VB, ACT((t) - 1)); MASKT(PX0, PX1, (t)); partialSM<MODE>(PX0, PX1, m_reg, mnX, alX, false);                    \
        if constexpr (!C::F8QK) __syncthreads();                                                                              \
        if ((t) + 1 < NT) { VMW(); if constexpr (C::F8QK) SWRITE3(NX3(bq)); else SWRITE_H(SB); }                              \
        if constexpr (C::F8QK) bq = NX3(bq);                                                                                  \
        RESC(alX); __syncthreads(); } while (0)
    for (int t = 1; t + 1 < NT; t += 2) {
        HALF_STEP(pB0, pB1, mnB, alB, pA0, pA1, alA, t, 1, 0, 0);
        HALF_STEP(pA0, pA1, mnA, alA, pB0, pB1, alB, t + 1, 0, 1, 1);
    }
    {
    int lane_t; asm volatile("v_mbcnt_lo_u32_b32 %0, -1, 0\n\tv_mbcnt_hi_u32_b32 %0, -1, %0" : "=v"(lane_t));
    const int lane = lane_t, r32 = lane & 31, hi = lane >> 5, tid_t = wid * 64 + lane, sr = tid_t >> 4, sc = (tid_t & 15) * 8, kws = KSWZ(sr, sc * 2), kr = tid_t >> 3, kc = tid_t & 7;
    const int qm = qlo + r32 - 4 * hi; (void)kr; (void)kc;
    const bool even = (NT & 1) == 0;
    if (even) { SBAR(); QKT(1, pB0, pB1, NT - 1); SBAR(); }
    int nq_ = nxt.qrow, nkv_ = nxt.kvrow, nkp_ = nxt.kprow, kbn_ = kbn;
    asm volatile("" : "+s"(nq_), "+s"(nkv_), "+s"(nkp_), "+s"(kbn_));
    SLOAD_H(KBASE8(nkv_), VBASE(nkv_, nkp_), KPBASE8(nkp_), kbn_); SBAR();
#pragma unroll
    for (int d0 = 0; d0 < NQR; ++d0) S.qr[d0] = load8(a.Q + (size_t)(nq_ + wid * QBLK + r32) * C::DK + d0 * 16 + hi * 8);
    SBAR();
    FIN(pA0, pA1, alA); SBAR();
    PV(0, ACT(even ? NT - 2 : NT - 1));
    if (even) { MASKT(pB0, pB1, NT - 1); partialSM<MODE>(pB0, pB1, m_reg, mnB, alB, false); __syncthreads(); RESC(alB);
        FIN(pB0, pB1, alB); SBAR(); PV(1, ACT(NT - 1)); }
    if constexpr (C::F8PV) asm volatile("s_nop 15\n\ts_nop 15" : "+v"(o[0]), "+v"(o[1]), "+v"(o[2]), "+v"(o[3]));
    SBAR(); SEAM_K0();
    if constexpr (NQR < NQ) {
#pragma unroll
        for (int d0 = NQR; d0 < NQ; ++d0) S.qr[d0] = load8(a.Q + (size_t)(nq_ + wid * QBLK + r32) * C::DK + d0 * 16 + hi * 8);
        SBAR(); }
    if (hi == 0) li_l[r32] = l_reg; asm volatile("s_waitcnt lgkmcnt(0)" ::: "memory");
    float rli[16];
#pragma unroll
    for (int r = 0; r < 16; ++r) rli[r] = __builtin_amdgcn_rcpf(li_l[crow(r, hi)]) * (C::F8PV ? 0.125f : 1.0f);
    int orow_ = cur.orow, hcol_ = cur.hcol; asm volatile("" : "+s"(orow_), "+s"(hcol_));
    if (a.o8 != 0.f) {
        unsigned char* Ob = (unsigned char*)a.O + (size_t)(orow_ + wid * QBLK) * ldo + hcol_; const float os = a.o8;
#pragma unroll
        for (int r = 0; r < 16; ++r) { const int orow = crow(r, hi);
#pragma unroll
            for (int d0 = 0; d0 < 4; ++d0) { const float v = __builtin_amdgcn_fmed3f(o[d0][r] * rli[r] * os, -448.f, 448.f);
                const float vn = __shfl_xor(v, 1);
                const int pk = __builtin_amdgcn_cvt_pk_fp8_f32(v, vn, 0, false) & 0xffff; const int pk2 = __shfl_xor(pk, 2);
                if ((r32 & 3) == 0) *(unsigned*)(Ob + (size_t)orow * ldo + d0 * 32 + r32) = (unsigned)pk | ((unsigned)pk2 << 16); } }
    } else {
    bf16_t* Ow = a.O + (size_t)(orow_ + wid * QBLK) * ldo + hcol_;
#pragma unroll
    for (int r = 0; r < 16; ++r) { const int orow = crow(r, hi);
#pragma unroll
        for (int d0 = 0; d0 < 4; ++d0) { const float v = o[d0][r] * rli[r];
            const float vn = __shfl_xor(v, 1);
            if ((r32 & 1) == 0) *(unsigned*)(Ow + (size_t)orow * ldo + d0 * 32 + r32) = cvt_pk_bf16(v, vn); } }
    }
    __syncthreads();
    }
#undef RESC
#undef KBASE
#undef ACT
#undef MASKT
#undef QKT
#undef SEAM_K0
#undef KB3
#undef VB3
#undef NX3
#undef PR3
#undef SWRITE3
#undef PVPREV
#undef HALF_STEP
#undef FIN
#undef PV
}
#undef ROW
#undef VMW
#undef VMWN
#undef SLOAD_H
#undef VBASE
#undef KBASE8
#undef KPBASE8
#undef SWRITE_HK
#undef SWRITE_HV
#undef SWRITE_H

__device__ inline int swa_nramp(int nqb, int W) { const int t = W - 1; const int n = t < 0 ? 0 : t / QB + 1; return n > nqb ? nqb : n; }
struct SwaItem { int bh, qb0, qb1; };
__device__ __forceinline__ SwaItem swa_decode(int L, int nqb, int nx, int nramp) {
    SwaItem it; it.bh = L / nx; const int x = L - it.bh * nx; const int ns = nqb - nramp;
    if (x < ns) { it.qb0 = it.qb1 = nqb - 1 - x; } else { it.qb0 = x - ns; it.qb1 = nramp - 1 - it.qb0; }
    return it;
}
template <int MODE>
__device__ __forceinline__ BlockRef make_ref(const AttnArgs& a, const SwaItem& it, int pass, int jskip0 = 0, int jskip1 = 0) {
    const int qb = pass ? it.qb1 : it.qb0, b = it.bh / a.nh, h = it.bh - b * a.nh, kvh = h / (a.nh / a.nhkv);
    BlockRef r;
    r.qrow = h * NTOK + b * SEQ + qb * QB; r.kvrow = kvh * NTOK + b * SEQ; r.kprow = b * SEQ; r.orow = b * SEQ + qb * QB; r.hcol = h * D; r.P0 = qb * QB;
    r.jlo = (MODE == 0) ? (pass ? jskip1 : jskip0) : swa_jlo(r.P0, a.W);
    if (MODE == 1) { r.m0 = a.sinks[h] * (1.0f / Cfg<MODE>::SCALE); r.l0 = 1.f; } else { r.m0 = -1e30f; r.l0 = 0.f; }
    return r;
}
template <int MODE>
__device__ __forceinline__ void attn_phase(char* lds, const AttnArgs& a, int G, int c, const int tid) {
    constexpr int nqb = SEQ / QB;
    const int nramp = swa_nramp(nqb, a.W), nx = (nramp + 1) / 2 + (nqb - nramp), total = nx * NBATCH * a.nh;
    int L = c; if (L >= total) return;
    const int wv = __builtin_amdgcn_readfirstlane(tid >> 6); (void)wv;
    SwaItem it = swa_decode(L, nqb, nx, nramp); int pass = 0; int cum_bh = -1; int js0 = 0, js1 = 0;
    if constexpr (Cfg<MODE>::BIAS) {
        { const f32x4* src = (const f32x4*)(a.cum + (size_t)it.bh * SEQ); f32x4* dst = (f32x4*)(lds + OFF_CUM); dst[tid] = src[tid]; dst[tid + 512] = src[tid + 512]; cum_bh = it.bh; }
        float* red = (float*)(lds + OFF_WS);
        const int b = it.bh / a.nh, h = it.bh - b * a.nh, lane = tid & 63;
        float km = 0.f;
        { const f32x4* kn = (const f32x4*)(a.nrm + ((size_t)(8 + h) * NTOK + (size_t)b * SEQ) * 4);
#pragma unroll
          for (int i = 0; i < 8; ++i) { const f32x4 v = kn[8 * tid + i]; km = fmaxf(km, (v[0] + v[1]) + (v[2] + v[3])); } }
        const int qbx = (tid < 256) ? it.qb0 : it.qb1;
        float qm; { const f32x4 v = ((const f32x4*)(a.nrm + ((size_t)h * NTOK + (size_t)b * SEQ + (size_t)qbx * QB) * 4))[tid & 255]; qm = (v[0] + v[1]) + (v[2] + v[3]); }
#pragma unroll
        for (int o = 1; o < 64; o <<= 1) { km = fmaxf(km, __shfl_xor(km, o)); qm = fmaxf(qm, __shfl_xor(qm, o)); }
        if (lane == 0) { red[wv] = km; red[8 + wv] = qm; }
        __syncthreads();
        float K2 = 0.f, Q20 = 0.f, Q21 = 0.f;
#pragma unroll
        for (int w = 0; w < 8; ++w) { K2 = fmaxf(K2, red[w]); if (w < 4) Q20 = fmaxf(Q20, red[8 + w]); else Q21 = fmaxf(Q21, red[8 + w]); }
        const float* nc = (const float*)(lds + OFF_CUM); const float Kn = sqrtf(K2);
        const float lim0 = -(32.0f / Cfg<MODE>::SCALE) - 2.04f * sqrtf(Q20) * Kn, lim1 = -(32.0f / Cfg<MODE>::SCALE) - 2.04f * sqrtf(Q21) * Kn;
        const float t00 = nc[it.qb0 * QB], t01 = nc[it.qb1 * QB];
        while (js0 < it.qb0 * (QB / KVBLK) && nc[js0 * KVBLK + KVBLK - 1] - t00 < lim0) ++js0;
        while (js1 < it.qb1 * (QB / KVBLK) && nc[js1 * KVBLK + KVBLK - 1] - t01 < lim1) ++js1;
        js0 = __builtin_amdgcn_readfirstlane(js0); js1 = __builtin_amdgcn_readfirstlane(js1);
        __syncthreads();
    }
    BlockRef cur = make_ref<MODE>(a, it, 0, js0, js1);
    Seam<MODE> S;
    attn_prime<MODE>(a, cur, lds, S, tid);
    bool first_item = true;
    for (;;) {
        if constexpr (Cfg<MODE>::BIAS) { if (it.bh != cum_bh) {
            const f32x4* src = (const f32x4*)(a.cum + (size_t)it.bh * SEQ); f32x4* dst = (f32x4*)(lds + OFF_CUM);
            int l_; asm volatile("v_mbcnt_lo_u32_b32 %0, -1, 0\n\tv_mbcnt_hi_u32_b32 %0, -1, %0" : "=v"(l_)); const int t2 = wv * 64 + l_;
            dst[t2] = src[t2]; dst[t2 + 512] = src[t2 + 512];
            cum_bh = it.bh; __syncthreads(); } }
        const bool more_pass = pass == 0 && it.qb1 != it.qb0, more_item = L + G < total, last = !more_pass && !more_item;
        SwaItem itn = it; int passn = pass + 1, Ln = L;
        if (!more_pass) { passn = 0; Ln = more_item ? L + G : L; itn = swa_decode(Ln, nqb, nx, nramp); }
        const bool nfirst = first_item && more_pass;
        const BlockRef nxt = last ? cur : make_ref<MODE>(a, itn, passn, nfirst ? js0 : 0, nfirst ? js1 : 0);
        attn_block<MODE>(a, cur, nxt, lds, S, tid);
        if (last) break;
        if (!more_pass) first_item = false;
        cur = nxt; it = itn; pass = passn; L = Ln;
    }
}
#undef KSWZ
#undef SBAR
}
constexpr size_t MiB = 1u << 20;
constexpr size_t WS_CTL = 0, CTL_ZERO_BYTES = 64 * 1024;
constexpr size_t WS_LOGF = 1 * MiB;
constexpr size_t WS_CUMF = 1 * MiB + 512 * 1024;
constexpr size_t WS_C128 = 2 * MiB, WS_S128 = 6 * MiB;
constexpr size_t WS_C64 = 10 * MiB, WS_S64 = 12 * MiB;
constexpr size_t WS_SSQ = 14 * MiB;
constexpr size_t WS_RT = 15 * MiB;
constexpr size_t RT_E = 0, RT_G = 128 * 1024, RT_P = 256 * 1024, RT_CNT = 384 * 1024, RT_META = 384 * 1024 + 8192;
constexpr size_t RT_ST1 = 512 * 1024, RT_ST2 = 640 * 1024;
constexpr size_t RT_CGU = 768 * 1024, RT_DGU = 832 * 1024, RT_CIN = 896 * 1024, RT_DIN = 904 * 1024;
constexpr size_t WS_W_IN0 = 16 * MiB, WS_W_OUT0 = 34 * MiB, WS_W_GU0 = 42 * MiB, WS_W_D0 = 86 * MiB, WS_W_IN1 = 108 * MiB, WS_W_UQ = 113 * MiB, WS_W_UKV = 116 * MiB, WS_W_OUT1 = 120 * MiB;
constexpr size_t WS_W_MGU = 128 * MiB, WS_W_MD = 576 * MiB;
constexpr size_t WS_XB = 800 * MiB, WS_QKV0 = 864 * MiB, WS_O0 = 1008 * MiB, WS_Y = 1072 * MiB, WS_H1 = 1200 * MiB, WS_H1B = 1328 * MiB;
constexpr size_t WS_NRM = 1200 * MiB;
constexpr size_t WS_ACT0 = 800 * MiB, WS_H2 = 1392 * MiB, WS_H2B = 1520 * MiB;
constexpr size_t WS_CQ = 1584 * MiB, WS_CKV = 1600 * MiB, WS_KPE = 1616 * MiB;
constexpr size_t WS_Q1 = 800 * MiB, WS_KN1 = 896 * MiB, WS_V1 = 960 * MiB, WS_O1 = 1200 * MiB;
constexpr size_t WS_H3 = 1600 * MiB, WS_H3B = 1728 * MiB;
constexpr size_t WS_Y3B = 1632 * MiB;
constexpr float YM_SC = 400.f;
constexpr size_t WS_XS = 800 * MiB, WS_ACT1 = 1200 * MiB, WS_YM = 1440 * MiB, WS_YM1 = 800 * MiB;
constexpr size_t WS_END = 1760 * MiB;
static_assert(WS_ACT1 + (size_t)MOE_TILES_MAX * 256 * FFE <= WS_YM && WS_YM + (size_t)MOE_TILES_MAX * 256 * DM * 2 <= WS_H3B && WS_ACT1 >= WS_Y + (size_t)NTOK * DM * 4, "moe map (Y stays intact until the last phase)");

constexpr int LDS_BYTES = 147456, LDS_MISC = 147456 - 256;
static_assert(att::LDS_BYTES <= LDS_MISC && pg8::STAGE_BYTES <= LDS_MISC, "LDS map");
constexpr int NPHASE = 15;

struct Params { const float* in[27]; float* out; unsigned char* ws; int ph_lo, ph_hi; int li, pad; double invf128[64]; double invf64[32]; };

__device__ __forceinline__ float wave_sum(float v) {
#pragma unroll
    for (int o = 1; o < 64; o <<= 1) v += __shfl_xor(v, o);
    return v;
}
__device__ __forceinline__ void sincos_dd(double a, float& s, float& c) {
    const double q = rint(a * 0.63661977236758134308);
    double r = fma(-q, 1.57079632679489655800, a); r = fma(-q, 6.12323399573676603587e-17, r);
    const int quad = (int)((long long)q & 3);
    const double r2 = r * r;
    const double sp = r * (1.0 + r2 * (-1.0 / 6 + r2 * (1.0 / 120 + r2 * (-1.0 / 5040 + r2 * (1.0 / 362880 + r2 * (-1.0 / 39916800))))));
    const double cp = 1.0 + r2 * (-0.5 + r2 * (1.0 / 24 + r2 * (-1.0 / 720 + r2 * (1.0 / 40320 + r2 * (-1.0 / 3628800 + r2 * (1.0 / 479001600))))));
    const double sv = (quad & 1) ? cp : sp, cv = (quad & 1) ? sp : cp;
    s = (float)((quad & 2) ? -sv : sv); c = (float)((quad == 1 || quad == 2) ? -cv : cv);
}

constexpr bool FP8_GU0 = true;
constexpr float WSC_I8GU = 2550.f, ASC_YI8 = 19.f;
constexpr float WSC_O = 512.f, ASC_O = 16.f;
constexpr float WSC_I8UP = 640.f, ASC_LI8 = 27.f;
constexpr float WSC_I8IN = 1280.f, ASC_XI8 = 27.f;
constexpr float WSC_DOWN = 1024.f, WSC_GU = 512.f, ASC_ACT = 16.f, ASC_X = 8.f, ASC_Y = 4.f;
struct CvtItem { const float* src; int srcN; bf16_t* dst; int K, n0, k0; int scol; const float* ksc; float f8s; };
__device__ __forceinline__ int rp128(int p) { return ((p >> 2) & 1) * 64 + (p >> 3) * 4; }
__device__ __forceinline__ int rp64(int p) { return ((p >> 2) & 1) * 32 + (p >> 3) * 4; }
__device__ __forceinline__ CvtItem cvt_decode(const Params& P, int it, int tid) {
    CvtItem c; c.ksc = nullptr; c.f8s = 0.f; int kind, nNb; const float* src2 = nullptr; unsigned char* ws = P.ws;
    if (it < 1152) { kind = 1; c.src = P.in[2]; c.srcN = 4616; c.dst = (bf16_t*)(ws + WS_W_IN0); c.K = 2048; nNb = 72; }
    else if ((it -= 1152) < 512) { kind = 0; c.src = P.in[5]; c.srcN = 2048; c.dst = (bf16_t*)(ws + WS_W_OUT0); c.K = 2048; nNb = 32; }
    else if ((it -= 512) < 2816) { kind = 2; c.src = P.in[8]; src2 = P.in[9]; c.srcN = FFD; c.dst = (bf16_t*)(ws + WS_W_GU0); c.K = 2048; nNb = 176; c.f8s = FP8_GU0 ? WSC_GU : 0.f; c.ksc = P.in[6]; }
    else if ((it -= 2816) < 1408) { kind = 0; c.src = P.in[10]; c.srcN = 2048; c.dst = (bf16_t*)(ws + WS_W_D0); c.K = FFD; nNb = 32; c.f8s = WSC_DOWN; }
    else if ((it -= 1408) < 320) { kind = 3; c.src = P.in[13]; c.srcN = 1088; c.dst = (bf16_t*)(ws + WS_W_IN1); c.K = 2048; nNb = 20; c.ksc = P.in[11]; }
    else if ((it -= 320) < 192) { kind = 4; c.src = P.in[15]; c.srcN = 3072; c.dst = (bf16_t*)(ws + WS_W_UQ); c.K = 512; nNb = 48; c.ksc = P.in[14]; }
    else if ((it -= 192) < 256) { kind = 5; c.src = P.in[17]; c.srcN = 4096; c.dst = (bf16_t*)(ws + WS_W_UKV); c.K = 512; nNb = 64; c.ksc = P.in[16]; }
    else if ((it -= 256) < 512) { kind = 0; c.src = P.in[18]; c.srcN = 2048; c.dst = (bf16_t*)(ws + WS_W_OUT1); c.K = 2048; nNb = 32; }
    else if ((it -= 512) < 28672) { const int e = it / 3584; it -= e * 3584; kind = 2; c.src = P.in[22] + (size_t)e * 2048 * FFE; src2 = P.in[23] + (size_t)e * 2048 * FFE; c.srcN = FFE;
        c.dst = (bf16_t*)((unsigned char*)(ws + WS_W_MGU) + (size_t)e * 14336 * 2048); c.K = 2048; nNb = 224; c.f8s = WSC_GU; }
    else { it -= 28672; const int e = it / 1792; it -= e * 1792; kind = 0; c.src = P.in[24] + (size_t)e * FFE * 2048; c.srcN = 2048; c.dst = (bf16_t*)((unsigned char*)(ws + WS_W_MD) + (size_t)e * 2048 * FFE); c.K = FFE; nNb = 32; c.f8s = WSC_DOWN; }
    const int kb = it / nNb, nb = it - kb * nNb; c.k0 = kb * 128; c.n0 = nb * 64;
    const int n = c.n0 + 4 * (tid & 15); int sc = n;
    if (kind == 1) { if (n >= 4352) sc = 4360 + (n - 4352); else if (n >= 4096) sc = 4104 + ((n - 4096) >> 7) * 128 + rp128((n - 4096) & 127); else if (n >= 3072) sc = 3080 + ((n - 3072) >> 7) * 128 + rp128((n - 3072) & 127); }
    else if (kind == 2) { const int t = n >> 8, r = n & 255; if (r < 128) sc = t * 128 + r; else { sc = t * 128 + r - 128; c.src = src2; } }
    else if (kind == 3) { if (n >= 1088) sc = -1; else if (n >= 1024) sc = 1024 + rp64(n - 1024); }
    else if (kind == 4) { if (n < 2048) sc = (n >> 7) * 192 + (n & 127); else sc = ((n - 2048) >> 6) * 192 + 128 + rp64((n - 2048) & 63); }
    else if (kind == 5) { if (n < 2048) sc = (n >> 7) * 256 + (n & 127); else sc = ((n - 2048) >> 7) * 256 + 128 + ((n - 2048) & 127); }
    c.scol = sc; return c;
}
constexpr int CVT_ITEMS = 7168 + 28672 + 14336;
struct CvtMat { const float* src; const float* src2; unsigned char* dst; const float* ksc; float f8s; int srcN, K, nNb, nItems, kind, deal, i8; };
__device__ __forceinline__ CvtMat cvt_matrix(const Params& P, int mi) {
    CvtMat m; m.src2 = nullptr; m.ksc = nullptr; m.f8s = 0.f; m.kind = 0; m.deal = 0; m.i8 = 0; unsigned char* ws = P.ws;
    if (mi >= 16) { const int e = mi - 16; m.src = P.in[24] + (size_t)e * FFE * 2048; m.srcN = 2048; m.dst = ws + WS_W_MD + (size_t)e * 2048 * FFE; m.K = FFE; m.nNb = 32; m.f8s = WSC_DOWN; m.deal = 2; }
    else if (mi >= 8) { const int e = mi - 8; m.kind = 2; m.src = P.in[22] + (size_t)e * 2048 * FFE; m.src2 = P.in[23] + (size_t)e * 2048 * FFE; m.srcN = FFE; m.dst = ws + WS_W_MGU + (size_t)e * 14336 * 2048; m.K = 2048; m.nNb = 224; m.f8s = WSC_I8GU; m.i8 = 1; m.deal = 1; }
    else if (mi == 0) { m.kind = 1; m.src = P.in[2]; m.srcN = 4616; m.dst = ws + WS_W_IN0; m.K = 2048; m.nNb = 72; m.f8s = WSC_I8IN; m.i8 = 1; }
    else if (mi == 1) { m.src = P.in[5]; m.srcN = 2048; m.dst = ws + WS_W_OUT0; m.K = 2048; m.nNb = 32; m.f8s = WSC_O; }
    else if (mi == 2) { m.kind = 2; m.src = P.in[8]; m.src2 = P.in[9]; m.srcN = FFD; m.dst = ws + WS_W_GU0; m.K = 2048; m.nNb = 176; m.f8s = WSC_I8GU; m.i8 = 1; m.ksc = P.in[6]; m.deal = 1; }
    else if (mi == 3) { m.src = P.in[10]; m.srcN = 2048; m.dst = ws + WS_W_D0; m.K = FFD; m.nNb = 32; m.f8s = WSC_DOWN; m.deal = 3; }
    else if (mi == 4) { m.kind = 3; m.src = P.in[13]; m.srcN = 1088; m.dst = ws + WS_W_IN1; m.K = 2048; m.nNb = 20; m.ksc = P.in[11]; m.f8s = WSC_I8IN; m.i8 = 1; }
    else if (mi == 5) { m.kind = 4; m.src = P.in[15]; m.srcN = 3072; m.dst = ws + WS_W_UQ; m.K = 512; m.nNb = 48; m.ksc = P.in[14]; m.f8s = WSC_I8UP; m.i8 = 1; }
    else if (mi == 6) { m.kind = 5; m.src = P.in[17]; m.srcN = 4096; m.dst = ws + WS_W_UKV; m.K = 512; m.nNb = 64; m.ksc = P.in[16]; m.f8s = WSC_I8UP; m.i8 = 1; }
    else { m.src = P.in[18]; m.srcN = 2048; m.dst = ws + WS_W_OUT1; m.K = 2048; m.nNb = 32; m.f8s = WSC_O; }
    m.nItems = (m.K / 128) * m.nNb; return m;
}
struct CvtIter { CvtMat m; int mi, r, kb, nb, stride; };
__device__ __forceinline__ void cvt_kn(const CvtMat& m, int r, int& kb, int& nb) {
    if (m.deal == 1) { const int g = r >> 8, w = r & 255; kb = w & 15; nb = g * 16 + (w >> 4); }
    else if (m.deal == 2) { const int g = r >> 8, w = r & 255; kb = g * 8 + (w & 7); nb = w >> 3; }
    else if (m.deal == 3) { const int g = r >> 7, w = r & 127; kb = g * 4 + (w & 3); nb = w >> 2; }
    else { kb = r / m.nNb; nb = r - kb * m.nNb; }
}
struct CvtDesc { unsigned char* dptr; int K; float f8s; int i8; };
__device__ __forceinline__ void cvt_issue(const Params& P, CvtIter& I, int tid, f32x4 (&v)[4], CvtDesc& d) {
    const int n4 = tid & 15, kk = tid >> 4, n = I.nb * 64 + 4 * n4, k0 = I.kb * 128, kind = I.m.kind;
    const float* s = I.m.src; int sc = n;
    if (kind == 1) { if (n >= 4352) sc = 4360 + (n - 4352); else if (n >= 4096) sc = 4104 + ((n - 4096) >> 7) * 128 + rp128((n - 4096) & 127); else if (n >= 3072) sc = 3080 + ((n - 3072) >> 7) * 128 + rp128((n - 3072) & 127); }
    else if (kind == 2) { const int t = n >> 8, r = n & 255; if (r < 128) sc = t * 128 + r; else { sc = t * 128 + r - 128; s = I.m.src2; } }
    else if (kind == 3) { if (n >= 1088) sc = -1; else if (n >= 1024) sc = 1024 + rp64(n - 1024); }
    else if (kind == 4) { if (n < 2048) sc = (n >> 7) * 192 + (n & 127); else sc = ((n - 2048) >> 6) * 192 + 128 + rp64((n - 2048) & 63); }
    else if (kind == 5) { if (n < 2048) sc = (n >> 7) * 256 + (n & 127); else sc = ((n - 2048) >> 7) * 256 + 128 + ((n - 2048) & 127); }
    d.K = I.m.K; d.f8s = I.m.f8s; d.i8 = I.m.i8; if (kind == 1) { const int n0 = I.nb * 64; if ((n0 >= 2048 && n0 < 3072) || n0 >= 4352) d.f8s *= 2.f; }
    if (kind == 5 && I.nb * 64 >= 2048) d.f8s *= 2.f;
    d.dptr = I.m.dst + ((size_t)(I.nb * 64) * I.m.K + k0) * (I.m.f8s != 0.f ? 1 : 2);
    if (sc >= 0) { const float* p0 = s + (size_t)(k0 + kk) * I.m.srcN + sc; const size_t st = (size_t)32 * I.m.srcN;
#pragma unroll
        for (int p = 0; p < 4; ++p) v[p] = __builtin_nontemporal_load((const f32x4*)(p0 + p * st)); }
    else {
#pragma unroll
        for (int p = 0; p < 4; ++p) v[p] = (f32x4){0.f, 0.f, 0.f, 0.f}; }
    if (I.m.ksc) {
#pragma unroll
        for (int p = 0; p < 4; ++p) v[p] = v[p] * I.m.ksc[k0 + kk + 32 * p]; }
    I.r += I.stride;
    while (I.mi < 24 && I.r >= I.m.nItems) { I.r -= I.m.nItems; ++I.mi; if (I.mi < 24) I.m = cvt_matrix(P, I.mi); }
    cvt_kn(I.m, I.r, I.kb, I.nb);
}
constexpr int CVT_P2 = 68;
__device__ __forceinline__ void cvt_to_lds2(LAS float* scr, int tid, const f32x4 (&v)[4]) {
    const int n4 = tid & 15, kk = tid >> 4;
#pragma unroll
    for (int p = 0; p < 4; ++p) { const int k = kk + 32 * p; *(LAS f32x4*)(scr + k * CVT_P2 + 4 * (n4 ^ ((k >> 4) & 7))) = v[p]; }
}
__device__ __forceinline__ void cvt_store2(const LAS float* scr, int tid, const CvtDesc& d) {
    if (d.f8s != 0.f) {
        const int ch = tid & 7, n = tid >> 3; const LAS float* s = scr + (16 * ch) * CVT_P2 + (n ^ (4 * ch)); float t[16];
#pragma unroll
        for (int j = 0; j < 16; ++j) t[j] = s[j * CVT_P2] * d.f8s;
        const f32x4 t0 = (f32x4){t[0], t[1], t[2], t[3]}, t1 = (f32x4){t[4], t[5], t[6], t[7]}, t2 = (f32x4){t[8], t[9], t[10], t[11]}, t3 = (f32x4){t[12], t[13], t[14], t[15]};
        const u32x2 a = d.i8 ? pg8::pack8i8(t0, t1) : pg8::pack8fp8(t0, t1), b = d.i8 ? pg8::pack8i8(t2, t3) : pg8::pack8fp8(t2, t3);
        __builtin_nontemporal_store((u32x4){a.x, a.y, b.x, b.y}, (u32x4*)(d.dptr + (size_t)n * d.K + 16 * ch));
        return; }
    const int ch = tid & 15;
#pragma unroll
    for (int q = 0; q < 2; ++q) { const int n = (tid >> 4) + 32 * q; const LAS float* s = scr + (8 * ch) * CVT_P2 + (n ^ (4 * (ch >> 1)));
        u32x4 w; w.x = cvt_pk_bf16(s[0], s[CVT_P2]); w.y = cvt_pk_bf16(s[2 * CVT_P2], s[3 * CVT_P2]); w.z = cvt_pk_bf16(s[4 * CVT_P2], s[5 * CVT_P2]); w.w = cvt_pk_bf16(s[6 * CVT_P2], s[7 * CVT_P2]);
        *(u32x4*)(d.dptr + ((size_t)n * d.K + 8 * ch) * 2) = w; }
}
__device__ __forceinline__ void p0_convert(const Params& P, LAS unsigned char* lds, const int tid, const int first, const int stride, const int end) {
    LAS float* scrA = (LAS float*)lds; LAS float* scrB = (LAS float*)(lds + 34816);
    if (first >= end) return; const int cnt = (end - first + stride - 1) / stride;
    CvtIter I; { int base = 0, mi = 0; for (;; ++mi) { I.m = cvt_matrix(P, mi); if (first < base + I.m.nItems) break; base += I.m.nItems; }
        I.mi = mi; I.r = first - base; I.stride = stride; cvt_kn(I.m, I.r, I.kb, I.nb); }
    CvtDesc d0, d1, d2, d3; f32x4 v0[4], v1[4], v2[4], v3[4]; d1 = d2 = d3 = CvtDesc{nullptr, 0, 0.f, 0};
    cvt_issue(P, I, tid, v0, d0);
    if (cnt > 1) cvt_issue(P, I, tid, v1, d1);
    if (cnt > 2) cvt_issue(P, I, tid, v2, d2);
    if (cnt > 3) cvt_issue(P, I, tid, v3, d3);
    int i = 0;
#define CVT_STAGE(v, d, scr) { if (i >= cnt) break; cvt_to_lds2(scr, tid, v); __syncthreads(); const CvtDesc o_ = d; if (i + 4 < cnt) cvt_issue(P, I, tid, v, d); cvt_store2(scr, tid, o_); ++i; }
    for (;;) { CVT_STAGE(v0, d0, scrA) CVT_STAGE(v1, d1, scrB) CVT_STAGE(v2, d2, scrA) CVT_STAGE(v3, d3, scrB) }
#undef CVT_STAGE
    __syncthreads();
}
__device__ __forceinline__ void p0_colsums(const Params& P, LAS unsigned char* lds, const int tid) {
    LAS f32x4* red = (LAS f32x4*)lds;
    for (int s = blockIdx.x; s < 176 + 20; s += gridDim.x) {
        const bool gu = s < 176; const int it = gu ? (1152 + 512 + s) : (1152 + 512 + 2816 + 1408 + (s - 176));
        const CvtItem c = cvt_decode(P, it, tid); const float* gv = c.ksc; const float* bv = gu ? P.in[7] : P.in[12];
        const int n4 = tid & 15, kk = tid >> 4; f32x4 ag = (f32x4){0.f, 0.f, 0.f, 0.f}, ab = ag;
        if (c.scol >= 0) {
#pragma unroll 16
            for (int k = kk; k < 2048; k += 32) { const f32x4 w = *(const f32x4*)(c.src + (size_t)k * c.srcN + c.scol); ag = ag + w * gv[k]; ab = ab + w * bv[k]; } }
        red[(kk * 16 + n4) * 2] = ag; red[(kk * 16 + n4) * 2 + 1] = ab;
        __syncthreads();
        if (tid < 16) { f32x4 sg = (f32x4){0.f, 0.f, 0.f, 0.f}, sb = sg;
            for (int q = 0; q < 32; ++q) { sg = sg + red[(q * 16 + tid) * 2]; sb = sb + red[(q * 16 + tid) * 2 + 1]; }
            float* Cv = (float*)(P.ws + WS_RT + (gu ? RT_CGU : RT_CIN)); float* Dv = (float*)(P.ws + WS_RT + (gu ? RT_DGU : RT_DIN)); const int n = c.n0 + 4 * tid;
            *(f32x4*)(Cv + n) = sg; *(f32x4*)(Dv + n) = sb; }
        __syncthreads();
    }
}
__device__ __forceinline__ void colsums_q(const Params& P, const int tid, const int w0, const int nw) {
    const int lane = tid & 63, wave = tid >> 6;
    for (int mat = 0; mat < 2; ++mat) {
        const signed char* Wq = (const signed char*)(P.ws + (mat == 0 ? WS_W_GU0 : WS_W_IN1)); const int nrows = mat == 0 ? 2 * FFD : 1280;
        const float* gv = mat == 0 ? P.in[6] : P.in[11]; const float* bv = mat == 0 ? P.in[7] : P.in[12]; const float inv = 1.0f / (mat == 0 ? WSC_I8GU : WSC_I8IN);
        float* Cv = (float*)(P.ws + WS_RT + (mat == 0 ? RT_CGU : RT_CIN)); float* Dv = (float*)(P.ws + WS_RT + (mat == 0 ? RT_DGU : RT_DIN));
        float ratio[32];
#pragma unroll
        for (int i = 0; i < 8; ++i) { const f32x4 g4 = *(const f32x4*)(gv + 32 * lane + 4 * i), b4 = *(const f32x4*)(bv + 32 * lane + 4 * i);
#pragma unroll
            for (int j = 0; j < 4; ++j) ratio[4 * i + j] = b4[j] / g4[j]; }
        for (int n = w0 * 8 + wave; n < nrows; n += nw * 8) {
            const u32x4 a = *(const u32x4*)(Wq + (size_t)n * 2048 + 32 * lane), b = *(const u32x4*)(Wq + (size_t)n * 2048 + 32 * lane + 16);
            float sc = 0.f, sd = 0.f;
#pragma unroll
            for (int i = 0; i < 8; ++i) { const unsigned w = i < 4 ? a[i] : b[i - 4];
#pragma unroll
                for (int j = 0; j < 4; ++j) { const float v = (float)((int)(w << (24 - 8 * j)) >> 24); sc += v; sd = fmaf(v, ratio[4 * i + j], sd); } }
            sc = wave_sum(sc); sd = wave_sum(sd);
            if (lane == 0) { Cv[n] = sc * inv; Dv[n] = sd * inv; }
        }
    }
}
__device__ __forceinline__ void xprep_row(const f32x4 (&v)[8], const int m, LAS float* wf, bf16_t* XB, float* LOGF, const float* bfg, const int lane) {
        unsigned* o4 = (unsigned*)((unsigned char*)XB + (size_t)m * DM) + lane;
#pragma unroll
        for (int j = 0; j < 8; ++j) o4[64 * j] = pg8::pack4i8(v[j] * ASC_XI8);
        float f[8];
#pragma unroll
        for (int e = 0; e < 8; ++e) { float s = 0.f;
#pragma unroll
            for (int j = 0; j < 8; ++j) { const f32x4 w = *(const LAS f32x4*)(wf + e * 2048 + 256 * j + 4 * lane); s = fmaf(v[j][0], w[0], s); s = fmaf(v[j][1], w[1], s); s = fmaf(v[j][2], w[2], s); s = fmaf(v[j][3], w[3], s); }
            f[e] = wave_sum(s); }
        if (lane < 8) { float z = 0.f;
#pragma unroll
            for (int e = 0; e < 8; ++e) z = (lane == e) ? f[e] : z;
            z += bfg[lane];
            LOGF[(size_t)m * 8 + lane] = fminf(z, 0.f) - log1pf(expf(-fabsf(z))); }
}
__device__ __forceinline__ void p0_xprep(const Params& P, LAS unsigned char* lds, const int tid) {
    const int lane = tid & 63, wave = tid >> 6, G = gridDim.x;
    LAS float* wf = (LAS float*)(lds + 69632);
    { float* st = (float*)(P.ws + WS_RT + RT_ST1); for (int i = blockIdx.x * 512 + tid; i < NTOK * 4; i += gridDim.x * 512) st[i] = 0.f; }
    const float* w_in0 = P.in[2];
    for (int idx = tid; idx < 16384; idx += 512) { const int k = idx >> 3, e = idx & 7; wf[e * 2048 + k] = w_in0[(size_t)k * 4616 + 3072 + e]; }
    __syncthreads();
    const float* x = P.in[0]; bf16_t* XB = (bf16_t*)(P.ws + WS_XB); float* LOGF = (float*)(P.ws + WS_LOGF); const float* bfg = P.in[3];
    { const int step = G * 8; int m = blockIdx.x * 8 + wave; f32x4 va[8], vb[8];
#define XP_LOAD(v, mm) { const f32x4* xr_ = (const f32x4*)(x + (size_t)(mm) * DM) + lane; _Pragma("unroll") for (int j = 0; j < 8; ++j) v[j] = __builtin_nontemporal_load(xr_ + 64 * j); }
      if (m < NTOK) XP_LOAD(va, m)
      while (m < NTOK) {
        asm volatile("" ::: "memory");
        if (m + step < NTOK) XP_LOAD(vb, m + step)
        xprep_row(va, m, wf, XB, LOGF, bfg, lane);
        m += step; if (m >= NTOK) break;
        asm volatile("" ::: "memory");
        if (m + step < NTOK) XP_LOAD(va, m + step)
        xprep_row(vb, m, wf, XB, LOGF, bfg, lane);
        m += step; }
#undef XP_LOAD
    }
    const int* pos = (const int*)P.in[1];
    float* C128 = (float*)(P.ws + WS_C128); float* S128 = (float*)(P.ws + WS_S128); float* C64 = (float*)(P.ws + WS_C64); float* S64 = (float*)(P.ws + WS_S64);
    for (int idx = blockIdx.x * 512 + tid; idx < NTOK * 64; idx += G * 512) { const int m = idx >> 6, i = idx & 63; float s, c; sincos_dd((double)pos[m] * P.invf128[i], s, c); C128[idx] = c; S128[idx] = s; }
    for (int idx = blockIdx.x * 512 + tid; idx < NTOK * 32; idx += G * 512) { const int m = idx >> 5, i = idx & 31; float s, c; sincos_dd((double)pos[m] * P.invf64[i], s, c); C64[idx] = c; S64[idx] = s; }
}
__device__ __forceinline__ void p1_cumsum(const Params& P, LAS unsigned char* lds, const int tid) {
    const int lane = tid & 63, wave = tid >> 6;
    LAS double* wt = (LAS double*)lds;
    for (int w = blockIdx.x; w < 32; w += gridDim.x) {
        const int b = w >> 3, h = w & 7; const float* LOGF = (const float*)(P.ws + WS_LOGF);
        double e[8]; double s = 0.0;
#pragma unroll
        for (int i = 0; i < 8; ++i) { s += (double)LOGF[((size_t)b * SEQ + 8 * tid + i) * 8 + h]; e[i] = s; }
        double inc = s;
#pragma unroll
        for (int o = 1; o < 64; o <<= 1) { const double t = __shfl_up(inc, o); if (lane >= o) inc += t; }
        if (lane == 63) wt[wave] = inc;
        __syncthreads();
        double base = inc - s;
        for (int k = 0; k < wave; ++k) base += wt[k];
        float* out = (float*)(P.ws + WS_CUMF) + (size_t)w * SEQ + 8 * tid;
#pragma unroll
        for (int i = 0; i < 8; ++i) out[i] = (float)((base + e[i]) * -11.313708498984761);
        __syncthreads();
    }
}

__device__ __forceinline__ void ln_norm2(f32x4 (&v)[8], const float* g, const float* b, int lane, float& mean_o, float& rstd_o) {
    float s = 0.f;
#pragma unroll
    for (int j = 0; j < 8; ++j) s += (v[j][0] + v[j][1]) + (v[j][2] + v[j][3]);
    const float mean = wave_sum(s) * (1.f / DM); float s2 = 0.f;
#pragma unroll
    for (int j = 0; j < 8; ++j) { v[j] = v[j] - mean; s2 += (v[j][0] * v[j][0] + v[j][1] * v[j][1]) + (v[j][2] * v[j][2] + v[j][3] * v[j][3]); }
    const float rstd = 1.f / sqrtf(wave_sum(s2) * (1.f / DM) + LN_EPS);
#pragma unroll
    for (int j = 0; j < 8; ++j) { const f32x4 gv = *((const f32x4*)g + lane + 64 * j), bv = *((const f32x4*)b + lane + 64 * j); v[j] = v[j] * rstd * gv + bv; }
    mean_o = mean; rstd_o = rstd;
}
__device__ __forceinline__ void ln_norm(f32x4 (&v)[8], const float* g, const float* b, int lane) { float m_, r_; ln_norm2(v, g, b, lane, m_, r_); }
__device__ __forceinline__ void ln_store(const f32x4 (&v)[8], float* hf, bf16_t* hb, size_t m, int lane, float f8s = 0.f) {
    if (hf) { f32x4* o = (f32x4*)(hf + m * DM) + lane;
#pragma unroll
        for (int j = 0; j < 8; ++j) __builtin_nontemporal_store(v[j], o + 64 * j); }
    if (hb && f8s != 0.f) { unsigned* o4 = (unsigned*)((unsigned char*)hb + m * DM) + lane;
#pragma unroll
        for (int j = 0; j < 8; ++j) { if (f8s < 0.f) { o4[64 * j] = pg8::pack4i8(v[j] * -f8s); continue; }
            const f32x4 t = v[j] * f8s; int w = __builtin_amdgcn_cvt_pk_fp8_f32(pg8::clamp448(t[0]), pg8::clamp448(t[1]), 0, false); w = __builtin_amdgcn_cvt_pk_fp8_f32(pg8::clamp448(t[2]), pg8::clamp448(t[3]), w, true); o4[64 * j] = (unsigned)w; } }
    else if (hb) { u32x2* o8 = (u32x2*)(hb + m * DM) + lane;
#pragma unroll
        for (int j = 0; j < 8; ++j) { u32x2 w; w.x = cvt_pk_bf16(v[j][0], v[j][1]); w.y = cvt_pk_bf16(v[j][2], v[j][3]); o8[64 * j] = w; } }
}
__device__ __forceinline__ f32x4 bf4x(const u32x2 a) { return (f32x4){__uint_as_float(a.x << 16), __uint_as_float(a.x & 0xffff0000u), __uint_as_float(a.y << 16), __uint_as_float(a.y & 0xffff0000u)}; }
__device__ __forceinline__ void ln3_router_phase(const Params& P, LAS unsigned char* lds, const int tid) {
    const int lane = tid & 63, wave = tid >> 6;
    LAS float* wr = (LAS float*)lds;
    LAS int* wcnt = (LAS int*)(lds + 65536);
    const float* w_router = P.in[21];
    for (int idx = tid; idx < 16384; idx += 512) { const int k = idx >> 3, e = idx & 7; wr[e * 2048 + k] = w_router[idx]; }
    __syncthreads();
    const bf16_t* Y = (const bf16_t*)(P.ws + WS_Y3B); bf16_t* H3B = (bf16_t*)(P.ws + WS_H3B); float* st3 = (float*)(P.ws + WS_RT + RT_ST1);
    int* rte = (int*)(P.ws + WS_RT + RT_E); float* rtg = (float*)(P.ws + WS_RT + RT_G); int* cntblk = (int*)(P.ws + WS_RT + RT_CNT);
    for (int c = blockIdx.x; c < NTOK / 64; c += gridDim.x) {
        int cnt[8];
#pragma unroll
        for (int e = 0; e < 8; ++e) cnt[e] = 0;
#pragma unroll 1
        for (int i = 0; i < 8; ++i) { const int m = c * 64 + wave * 8 + i; asm volatile("" ::: "memory");
            const u32x2* yr = (const u32x2*)(Y + (size_t)m * DM) + lane; f32x4 v[8];
#pragma unroll
            for (int j = 0; j < 8; ++j) v[j] = bf4x(yr[64 * j]);
            float mu3, rs3; ln_norm2(v, P.in[19], P.in[20], lane, mu3, rs3); ln_store(v, nullptr, H3B, (size_t)m, lane, -ASC_XI8);
            if (lane == 0) { st3[2 * m] = mu3; st3[2 * m + 1] = rs3; }
            float l[8];
#pragma unroll
            for (int e = 0; e < 8; ++e) { float s = 0.f;
#pragma unroll
                for (int j = 0; j < 8; ++j) { const f32x4 w = *(const LAS f32x4*)(wr + e * 2048 + 256 * j + 4 * lane); s = fmaf(v[j][0], w[0], s); s = fmaf(v[j][1], w[1], s); s = fmaf(v[j][2], w[2], s); s = fmaf(v[j][3], w[3], s); }
                l[e] = wave_sum(s); }
            float v1 = l[0]; int e1 = 0;
#pragma unroll
            for (int e = 1; e < 8; ++e) if (l[e] > v1) { v1 = l[e]; e1 = e; }
            float v2 = -__builtin_inff(); int e2 = 0;
#pragma unroll
            for (int e = 0; e < 8; ++e) if (e != e1 && l[e] > v2) { v2 = l[e]; e2 = e; }
            const float ex = expf(v2 - v1), g1 = 1.0f / (1.0f + ex), g2 = ex / (1.0f + ex);
            if (lane == 0) { rte[2 * m] = e1; rte[2 * m + 1] = e2; rtg[2 * m] = g1; rtg[2 * m + 1] = g2; }
#pragma unroll
            for (int e = 0; e < 8; ++e) cnt[e] += (e1 == e) + (e2 == e);
        }
        if (lane == 0) {
#pragma unroll
            for (int e = 0; e < 8; ++e) wcnt[wave * 8 + e] = cnt[e]; }
        __syncthreads();
        if (tid < 8) { int s = 0;
#pragma unroll
            for (int w = 0; w < 8; ++w) s += wcnt[w * 8 + tid];
            cntblk[c * 8 + tid] = s; }
        __syncthreads();
    }
}
__device__ __forceinline__ void perm_phase(const Params& P, LAS unsigned char* lds, const int tid) {
    const int lane = tid & 63, wave = tid >> 6;
    LAS int* pre = (LAS int*)lds;
    LAS int* tot = (LAS int*)(lds + 8192);
    LAS int* pst = (LAS int*)(lds + 8192 + 64);
    LAS int* posl = (LAS int*)(lds + 8192 + 128);
    const int* cntblk = (const int*)(P.ws + WS_RT + RT_CNT); int* meta = (int*)(P.ws + WS_RT + RT_META);
    { const int e = wave; int cv[4]; int s = 0;
#pragma unroll
      for (int i = 0; i < 4; ++i) { cv[i] = cntblk[(4 * lane + i) * 8 + e]; s += cv[i]; }
      int inc = s;
#pragma unroll
      for (int o = 1; o < 64; o <<= 1) { const int t = __shfl_up(inc, o); if (lane >= o) inc += t; }
      int ex = inc - s;
#pragma unroll
      for (int i = 0; i < 4; ++i) { pre[(4 * lane + i) * 8 + e] = ex; ex += cv[i]; }
      if (lane == 63) tot[e] = inc; }
    __syncthreads();
    if (tid == 0) { int ps = 0;
        for (int e = 0; e < 8; ++e) { pst[e] = ps; if (blockIdx.x == 0) meta[1 + e] = ps >> 8; ps += ((tot[e] + 255) >> 8) << 8; }
        if (blockIdx.x == 0) { meta[0] = ps >> 8; meta[9] = ps >> 8; } }
    __syncthreads();
    const int* rte = (const int*)(P.ws + WS_RT + RT_E); int* rtp = (int*)(P.ws + WS_RT + RT_P);
    const bf16_t* H3B = (const bf16_t*)(P.ws + WS_H3B); unsigned char* XS = (unsigned char*)(P.ws + WS_XS);
    for (int c = blockIdx.x; c < NTOK / 64; c += gridDim.x) {
        if (wave == 0) { const int t = c * 64 + lane; const int e1 = rte[2 * t], e2 = rte[2 * t + 1]; int p1 = 0, p2 = 0;
            const unsigned long long lt = (1ull << lane) - 1ull;
#pragma unroll
            for (int e = 0; e < 8; ++e) { const unsigned long long m1 = __ballot(e1 == e), m2 = __ballot(e2 == e); const int base = pst[e] + pre[c * 8 + e];
                if (e1 == e) p1 = base + __popcll(m1 & lt);
                if (e2 == e) p2 = base + __popcll(m1) + __popcll(m2 & lt); }
            rtp[2 * t] = p1; rtp[2 * t + 1] = p2; posl[2 * lane] = p1; posl[2 * lane + 1] = p2; }
        __syncthreads();
        for (int idx = wave; idx < 128; idx += 8) { const int t = c * 64 + (idx >> 1); const int d = posl[idx];
            const u32x4* s = (const u32x4*)((const unsigned char*)H3B + (size_t)t * DM) + lane; u32x4* o = (u32x4*)(XS + (size_t)d * DM) + lane;
            o[0] = s[0]; o[64] = s[64]; }
        __syncthreads();
    }
}
__device__ __forceinline__ f32x4 bf4(const u32x2 a) { return (f32x4){__uint_as_float(a.x << 16), __uint_as_float(a.x & 0xffff0000u), __uint_as_float(a.y << 16), __uint_as_float(a.y & 0xffff0000u)}; }
__device__ __forceinline__ f32x4 f84(const unsigned w) { return (f32x4){(float)(w & 0xffu), (float)((w >> 8) & 0xffu), (float)((w >> 16) & 0xffu), (float)(w >> 24)}; }
__device__ __forceinline__ void ln4_load_y(f32x4 (&y)[8], const unsigned char* YM, const unsigned char* YP, int p, int main_rows, int sk, size_t pstride, int lane) {
    if (p < main_rows) { const unsigned* r = (const unsigned*)(YM + (size_t)p * DM) + lane;
#pragma unroll
        for (int j = 0; j < 8; ++j) y[j] = f84(r[64 * j]) - 128.f; }
    else {
#pragma unroll
        for (int j = 0; j < 8; ++j) y[j] = (f32x4){0.f, 0.f, 0.f, 0.f};
        for (int k = 0; k < sk; ++k) { const unsigned* r = (const unsigned*)(YP + (size_t)k * pstride + (size_t)(p - main_rows) * DM) + lane;
#pragma unroll
            for (int j = 0; j < 8; ++j) y[j] = y[j] + (f84(r[64 * j]) - 128.f); } }
}
__device__ __forceinline__ void ln4_load_raw(unsigned (&r)[8], const unsigned char* YM, const unsigned char* YP, int p, int main_rows, int lane) {
    const unsigned* s = (const unsigned*)((p < main_rows) ? YM + (size_t)p * DM : YP + (size_t)(p - main_rows) * DM) + lane;
#pragma unroll
    for (int j = 0; j < 8; ++j) r[j] = __builtin_nontemporal_load(s + 64 * j);
}
__device__ __forceinline__ void ln4_fin_y(f32x4 (&y)[8], const unsigned (&r)[8], const unsigned char* YP, int p, int main_rows, int sk, size_t pstride, int lane) {
#pragma unroll
    for (int j = 0; j < 8; ++j) y[j] = f84(r[j]) - 128.f;
    if (p >= main_rows) for (int k = 1; k < sk; ++k) { const unsigned* s = (const unsigned*)(YP + (size_t)k * pstride + (size_t)(p - main_rows) * DM) + lane;
#pragma unroll
        for (int j = 0; j < 8; ++j) y[j] = y[j] + (f84(s[64 * j]) - 128.f); }
}
__device__ __forceinline__ void ln4_phase(const Params& P, const int tid) {
    const int lane = tid & 63, wave = tid >> 6;
    const bf16_t* Y = (const bf16_t*)(P.ws + WS_Y3B); const float* st3 = (const float*)(P.ws + WS_RT + RT_ST1); const unsigned char* YM = (const unsigned char*)(P.ws + WS_YM); const unsigned char* YP = (const unsigned char*)(P.ws + WS_YM1);
    const float* rtg = (const float*)(P.ws + WS_RT + RT_G); const int* rtp = (const int*)(P.ws + WS_RT + RT_P);
    const int nM = ((const int*)(P.ws + WS_RT + RT_META))[0]; int main_m, sk; pg8::splitk_plan(nM, 8, FFE / 128, gridDim.x, main_m, sk);
    const int main_rows = main_m * 256; const size_t pstride = (size_t)(nM - main_m) * 256 * DM;
#define LN4_LOAD(S, mm) \
        const float S##g1 = rtg[2 * (mm)] * (1.0f / YM_SC), S##g2 = rtg[2 * (mm) + 1] * (1.0f / YM_SC); const int S##p1 = __builtin_amdgcn_readfirstlane(rtp[2 * (mm)]), S##p2 = __builtin_amdgcn_readfirstlane(rtp[2 * (mm) + 1]); \
        const float S##mu = st3[2 * (mm)], S##rs = st3[2 * (mm) + 1]; u32x2 S##yr[8]; unsigned S##ra[8], S##rb[8]; \
        { const u32x2* yr_ = (const u32x2*)(Y + (size_t)(mm) * DM) + lane; _Pragma("unroll") for (int j = 0; j < 8; ++j) S##yr[j] = __builtin_nontemporal_load(yr_ + 64 * j); } \
        ln4_load_raw(S##ra, YM, YP, S##p1, main_rows, lane); ln4_load_raw(S##rb, YM, YP, S##p2, main_rows, lane);
#define LN4_FIN(S, mm, st) { f32x4 v[8], ya[8], yb[8]; ln4_fin_y(ya, S##ra, YP, S##p1, main_rows, sk, pstride, lane); ln4_fin_y(yb, S##rb, YP, S##p2, main_rows, sk, pstride, lane); \
        _Pragma("unroll") for (int j = 0; j < 8; ++j) { const f32x4 h3 = (bf4x(S##yr[j]) - S##mu) * S##rs * *((const f32x4*)P.in[19] + lane + 64 * j) + *((const f32x4*)P.in[20] + lane + 64 * j); \
            v[j] = h3 * DN_ALPHA + ya[j] * S##g1 + yb[j] * S##g2; } \
        ln_norm(v, P.in[25], P.in[26], lane); if (st) ln_store(v, P.out, nullptr, (size_t)(mm), lane); }
    for (int m = blockIdx.x * 8 + wave; m < NTOK; m += gridDim.x * 16) {
        const int mB_ = m + gridDim.x * 8; const bool hasB = mB_ < NTOK; const int mB = hasB ? mB_ : m;
        asm volatile("" ::: "memory");
        LN4_LOAD(a_, m) LN4_LOAD(b_, mB)
        LN4_FIN(a_, m, true)
        asm volatile("" ::: "memory");
        LN4_FIN(b_, mB, hasB)
    }
#undef LN4_LOAD
#undef LN4_FIN
}

__global__ void __launch_bounds__(512, 2) fwd_kernel(Params P) {
    extern __shared__ __attribute__((aligned(16))) unsigned char lds_raw[];
    LAS unsigned char* lds = (LAS unsigned char*)lds_raw;
    volatile LAS unsigned* MISC = (volatile LAS unsigned*)(lds + LDS_MISC);
    int wave_s = __builtin_amdgcn_readfirstlane((int)threadIdx.x >> 6); asm volatile("" : "+s"(wave_s));
#define TID() ({ int l_; asm volatile("v_mbcnt_lo_u32_b32 %0, -1, 0\n\tv_mbcnt_hi_u32_b32 %0, -1, %0" : "=v"(l_)); wave_s * 64 + l_; })
    { const int t0 = TID(); if (t0 < 16) MISC[t0] = 0u; }
    __syncthreads();
    unsigned char* ws = P.ws;
    XcdBarrier bar = xcd_barrier_post((unsigned*)(ws + WS_CTL) + P.li * XCD_BAR_WORDS, MISC + 8, TID());
    const int lo = P.ph_lo, hi = P.ph_hi, G = gridDim.x, cid = blockIdx.x;
#define IN(k) (lo <= (k) && (k) < hi)
#define SEAM(k) do { if (IN((k) + 1)) xcd_barrier(bar, TID()); } while (0)
    bf16_t* QKV0 = (bf16_t*)(ws + WS_QKV0);

    const float* ST1 = (const float*)(ws + WS_RT + RT_ST1); const float* ST2 = (const float*)(ws + WS_RT + RT_ST2);

    constexpr int CVT_LATE = 2560;
    if (IN(0)) { p0_convert(P, lds, TID(), cid, G, CVT_ITEMS - CVT_LATE); __syncthreads(); p0_xprep(P, lds, TID()); SEAM(0); }

    if (IN(1)) {
        p1_cumsum(P, lds, TID()); __syncthreads();
        pg8::Gemm g{(const bf16_t*)(ws + WS_XB), (const bf16_t*)(ws + WS_W_IN0), DM / 2, 0, 1.0f / (ASC_XI8 * WSC_I8IN)}; pg8::TileOrder S; S.init(NTOK / 256, 18, G, cid, nullptr, DM / 128);
        pg8::EpiQKV0 E{QKV0, (const float*)(ws + WS_C128), (const float*)(ws + WS_S128), (float*)(ws + WS_NRM)};
        pg8::gemm_phase<pg8::EpiQKV0, pg8::TileOrder, 2>(lds, g, S, E, TID());
        { const int nfull = (NTOK / 256 * 18) % G;
          if (nfull > 0 && cid >= nfull) { __syncthreads(); colsums_q(P, TID(), cid - nfull, G - nfull); p0_convert(P, lds, TID(), CVT_ITEMS - CVT_LATE + (cid - nfull), G - nfull, CVT_ITEMS); }
          else if (nfull == 0) { __syncthreads(); colsums_q(P, TID(), cid, G); p0_convert(P, lds, TID(), CVT_ITEMS - CVT_LATE + cid, G, CVT_ITEMS); } }
        SEAM(1);
    }
    if (IN(2)) {
        const size_t HS = (size_t)NTOK * 128;
        { att::AttnArgs a{QKV0, QKV0 + 8 * HS, QKV0 + 16 * HS, nullptr, (bf16_t*)(ws + WS_O0), (const float*)(ws + WS_CUMF), nullptr, 8, 8, 1 << 30, DM, (const float*)(ws + WS_NRM), ASC_O};
          att::attn_phase<0>((char*)lds_raw, a, G, cid, TID()); }
        __syncthreads();
        { att::AttnArgs a{QKV0 + 24 * HS, QKV0 + 32 * HS, QKV0 + 34 * HS, nullptr, (bf16_t*)(ws + WS_O0 + 1024), nullptr, P.in[4], 8, 2, 128, DM, nullptr, ASC_O};
          att::attn_phase<1>((char*)lds_raw, a, G, cid, TID()); }
        SEAM(2);
    }
    if (IN(3)) {
        pg8::Gemm g{(const bf16_t*)(ws + WS_O0), (const bf16_t*)(ws + WS_W_OUT0), DM / 2, 0}; pg8::TileOrder S; S.init(NTOK / 256, 8, G, cid, nullptr, DM / 128);
        pg8::EpiResLN<0, 3, true> E{(float*)(ws + WS_Y), P.in[0], nullptr, nullptr, nullptr, (float*)(ws + WS_RT + RT_ST1), (void*)(ws + WS_H1B), 1.0f / (ASC_O * WSC_O), ASC_YI8};
        pg8::gemm_phase<pg8::EpiResLN<0, 3, true>, pg8::TileOrder, true>(lds, g, S, E, TID()); SEAM(3);
    }
    if (IN(4)) {
        const float* Cv = (const float*)(ws + WS_RT + RT_CGU); const float* Dv = (const float*)(ws + WS_RT + RT_DGU);
        if constexpr (FP8_GU0) {
            pg8::Gemm g{(const bf16_t*)(ws + WS_H1B), (const bf16_t*)(ws + WS_W_GU0), DM / 2, 0, 1.0f / (ASC_YI8 * WSC_I8GU), ASC_ACT}; pg8::TileOrder S; S.init(NTOK / 256, 44, G, cid, nullptr, DM / 128);
            pg8::EpiSwiGLU<true, true, true> E{(void*)(ws + WS_ACT0), FFD, 1.0f, ASC_ACT, ST1, Cv, Dv};
            pg8::gemm_phase<pg8::EpiSwiGLU<true, true, true>, pg8::TileOrder, 2>(lds, g, S, E, TID());
        } else {
            pg8::Gemm g{(const bf16_t*)(ws + WS_H1B), (const bf16_t*)(ws + WS_W_GU0), DM, 0}; pg8::TileOrder S; S.init(NTOK / 256, 44, G, cid, nullptr, DM / 64);
            pg8::EpiSwiGLU<true, true> E{(void*)(ws + WS_ACT0), FFD, 1.0f, ASC_ACT, ST1, Cv, Dv};
            pg8::gemm_phase(lds, g, S, E, TID());
        }
        SEAM(4);
    }
    if (IN(5)) {
        pg8::Gemm g{(const bf16_t*)(ws + WS_ACT0), (const bf16_t*)(ws + WS_W_D0), FFD / 2, 0}; pg8::TileOrder S; S.init(NTOK / 256, 8, G, cid, nullptr, FFD / 128);
        pg8::EpiResLN<1, 3, true> E{(float*)(ws + WS_Y), (const float*)(ws + WS_Y), ST1, P.in[6], P.in[7], (float*)(ws + WS_RT + RT_ST2), (void*)(ws + WS_H2B), 1.0f / (ASC_ACT * WSC_DOWN), ASC_YI8};
        pg8::gemm_phase<pg8::EpiResLN<1, 3, true>, pg8::TileOrder, true>(lds, g, S, E, TID()); SEAM(5);
    }
    if (IN(6)) {
        pg8::Gemm g{(const bf16_t*)(ws + WS_H2B), (const bf16_t*)(ws + WS_W_IN1), DM / 2, 0, 1.0f / (ASC_YI8 * WSC_I8IN)}; pg8::TileOrder S; S.init(NTOK / 256, 4, G, cid, nullptr, DM / 128);
        pg8::EpiMlaDown E{(bf16_t*)(ws + WS_CQ), (bf16_t*)(ws + WS_CKV), (bf16_t*)(ws + WS_KPE), (float*)(ws + WS_SSQ), (const float*)(ws + WS_C64), (const float*)(ws + WS_S64), ST2,
                          (const float*)(ws + WS_RT + RT_CIN), (const float*)(ws + WS_RT + RT_DIN), ASC_LI8};
        pg8::gemm_phase<pg8::EpiMlaDown, pg8::TileOrder, 2>(lds, g, S, E, TID()); SEAM(6);
    }
    if (IN(7)) {
        const int G4 = G / 4;
        if (cid < G4) { pg8::Gemm g{(const bf16_t*)(ws + WS_H2B), (const bf16_t*)(ws + WS_W_IN1 + (size_t)1024 * DM), DM / 2, 0, 1.0f / (ASC_YI8 * WSC_I8IN)}; pg8::TileOrder S; S.init(NTOK / 256, 1, G4, cid, nullptr, DM / 128);
          pg8::EpiKpe E{(bf16_t*)(ws + WS_KPE), (const float*)(ws + WS_C64), (const float*)(ws + WS_S64), ST2, (const float*)(ws + WS_RT + RT_CIN), (const float*)(ws + WS_RT + RT_DIN)};
          pg8::gemm_phase<pg8::EpiKpe, pg8::TileOrder, 2>(lds, g, S, E, TID()); }
        else { pg8::Gemm g{(const bf16_t*)(ws + WS_CQ), (const bf16_t*)(ws + WS_W_UQ), 256, 0, 1.0f / (ASC_LI8 * WSC_I8UP)}; pg8::TileOrder S; S.init(NTOK / 256, 12, G - G4, cid - G4, nullptr, 512 / 128);
          pg8::EpiMlaQ E{(bf16_t*)(ws + WS_Q1), (const float*)(ws + WS_SSQ), (const float*)(ws + WS_C64), (const float*)(ws + WS_S64)};
          pg8::gemm_phase<pg8::EpiMlaQ, pg8::TileOrder, 2>(lds, g, S, E, TID()); }
        __syncthreads();
        { pg8::Gemm g{(const bf16_t*)(ws + WS_CKV), (const bf16_t*)(ws + WS_W_UKV), 256, 0, 1.0f / (ASC_LI8 * WSC_I8UP)}; pg8::TileOrder S; S.init(NTOK / 256, 8, G, cid, nullptr, 512 / 128);
          pg8::EpiMlaKV E{(bf16_t*)(ws + WS_KN1), (bf16_t*)(ws + WS_V1), (const float*)(ws + WS_SSQ)};
          pg8::gemm_phase<pg8::EpiMlaKV, pg8::TileOrder, 2>(lds, g, S, E, TID()); }
        __syncthreads();
        { pg8::Gemm g{(const bf16_t*)(ws + WS_CKV), (const bf16_t*)(ws + WS_W_UKV + (size_t)2048 * 512), 256, 0, 0.5f / (ASC_LI8 * WSC_I8UP)}; pg8::TileOrder S; S.init(NTOK / 256, 8, G, cid, nullptr, 512 / 128);
          pg8::EpiMlaVT E{(unsigned char*)(ws + WS_V1), (const float*)(ws + WS_SSQ), 8.0f};
          pg8::gemm_phase<pg8::EpiMlaVT, pg8::TileOrder, 2, true>(lds, g, S, E, TID()); }
        SEAM(7);
    }
    if (IN(8)) {
        att::AttnArgs a{(const bf16_t*)(ws + WS_Q1), (const bf16_t*)(ws + WS_KN1), (const bf16_t*)(ws + WS_V1), (const bf16_t*)(ws + WS_KPE), (bf16_t*)(ws + WS_O1), nullptr, nullptr, 16, 16, 1 << 30, DM, nullptr, ASC_O};
        att::attn_phase<2>((char*)lds_raw, a, G, cid, TID()); SEAM(8);
    }
    if (IN(9)) {
        pg8::Gemm g{(const bf16_t*)(ws + WS_O1), (const bf16_t*)(ws + WS_W_OUT1), DM / 2, 0}; pg8::TileOrder S; S.init(NTOK / 256, 8, G, cid, nullptr, DM / 128);
        pg8::EpiResLN<1, 4, false> E{(float*)(ws + WS_Y), (const float*)(ws + WS_Y), ST2, P.in[11], P.in[12], nullptr, (void*)(ws + WS_Y3B), 1.0f / (ASC_O * WSC_O), 0.f};
        pg8::gemm_phase<pg8::EpiResLN<1, 4, false>, pg8::TileOrder, true>(lds, g, S, E, TID()); SEAM(9);
    }
    if (IN(10)) { ln3_router_phase(P, lds, TID()); SEAM(10); }
    if (IN(11)) { perm_phase(P, lds, TID()); SEAM(11); }
    const int* meta = (const int*)(ws + WS_RT + RT_META);
    if (IN(12)) {
        pg8::Gemm g{(const bf16_t*)(ws + WS_XS), (const bf16_t*)(ws + WS_W_MGU), DM / 2, (size_t)14336 * 2048, 1.0f / (ASC_XI8 * WSC_I8GU), ASC_ACT}; pg8::TileOrder S; S.init(meta[0], 56, G, cid, meta + 1, DM / 128);
        pg8::EpiSwiGLU<true, false, true> E{(void*)(ws + WS_ACT1), FFE, 1.0f, ASC_ACT, nullptr, nullptr, nullptr};
        pg8::gemm_phase<pg8::EpiSwiGLU<true, false, true>, pg8::TileOrder, 2>(lds, g, S, E, TID()); SEAM(12);
    }
    if (IN(13)) {
        int main_m, sk; pg8::splitk_plan(meta[0], 8, FFE / 128, G, main_m, sk);
        pg8::Gemm g{(const bf16_t*)(ws + WS_ACT1), (const bf16_t*)(ws + WS_W_MD), FFE / 2, (size_t)2048 * FFE};
        { pg8::TileOrder S; S.init(main_m, 8, G, cid, meta + 1, FFE / 128);
          pg8::EpiBf16 E{(bf16_t*)(ws + WS_YM), DM, 0, 0, 1.0f / (ASC_ACT * WSC_DOWN), -YM_SC};
          pg8::gemm_phase<pg8::EpiBf16, pg8::TileOrder, true>(lds, g, S, E, TID()); }
        __syncthreads();
        pg8::SplitKOrder S; S.init(meta[0], 8, FFE / 128, G, cid, meta + 1);
        pg8::EpiBf16 E{(bf16_t*)(ws + WS_YM1), DM, main_m * 256, (size_t)(meta[0] - main_m) * 256 * DM, 1.0f / (ASC_ACT * WSC_DOWN), -YM_SC};
        pg8::gemm_phase<pg8::EpiBf16, pg8::SplitKOrder, true>(lds, g, S, E, TID()); SEAM(13);
    }
    if (IN(14)) { ln4_phase(P, TID()); }
#undef IN
#undef SEAM
#undef TID
}

extern "C" void kernel_launch(void* const* d_in, const int* in_sizes, int n_in, void* d_out, int out_size, void* d_ws, size_t ws_size, hipStream_t stream) {
    static int grid = 0;
    if (grid == 0) {
        if (n_in != 27 || out_size != NTOK * DM || ws_size < WS_END) { fprintf(stderr, "kernel_launch: unexpected shapes (n_in %d out %d ws %zu need %zu)\n", n_in, out_size, ws_size, (size_t)WS_END); grid = -1; return; }
        int dev = 0, cus = 0;
        if (hipGetDevice(&dev) != hipSuccess || hipDeviceGetAttribute(&cus, hipDeviceAttributeMultiprocessorCount, dev) != hipSuccess) { grid = -1; return; }
        if (hipFuncSetAttribute((const void*)fwd_kernel, hipFuncAttributeMaxDynamicSharedMemorySize, LDS_BYTES) != hipSuccess) { fprintf(stderr, "kernel_launch: hipFuncSetAttribute failed\n"); grid = -1; return; }
        int per_cu = 0;
        if (hipOccupancyMaxActiveBlocksPerMultiprocessor(&per_cu, (const void*)fwd_kernel, 512, LDS_BYTES) != hipSuccess || per_cu < 1) fprintf(stderr, "kernel_launch: occupancy query reports %d\n", per_cu);
        (void)hipGetLastError();
        grid = cus;
    }
    if (grid < 0) return;
    (void)hipMemsetAsync((char*)d_ws + WS_CTL, 0, CTL_ZERO_BYTES, stream);
    Params p{};
    for (int i = 0; i < 27; ++i) p.in[i] = (const float*)d_in[i];
    p.out = (float*)d_out; p.ws = (unsigned char*)d_ws;
    for (int i = 0; i < 64; ++i) p.invf128[i] = std::pow(10000.0, -2.0 * i / 128.0);
    for (int i = 0; i < 32; ++i) p.invf64[i] = std::pow(10000.0, -2.0 * i / 64.0);
#if defined(PROBE_REP_LO)
    p.ph_lo = 0; p.ph_hi = PROBE_REP_HI; p.li = 0; hipLaunchKernelGGL(fwd_kernel, dim3(grid), dim3(512), LDS_BYTES, stream, p);
    p.ph_lo = PROBE_REP_LO; p.ph_hi = PROBE_REP_HI; p.li = 1; hipLaunchKernelGGL(fwd_kernel, dim3(grid), dim3(512), LDS_BYTES, stream, p);
    if (PROBE_REP_HI < NPHASE) { p.ph_lo = PROBE_REP_HI; p.ph_hi = NPHASE; p.li = 2; hipLaunchKernelGGL(fwd_kernel, dim3(grid), dim3(512), LDS_BYTES, stream, p); }
#else
    p.ph_lo = 0; p.ph_hi = NPHASE; p.li = 0; hipLaunchKernelGGL(fwd_kernel, dim3(grid), dim3(512), LDS_BYTES, stream, p);
#endif
}
```
